# Optimizing an MI355X kernel written in HIP

```python
import jax, jax.numpy as jnp
from jax import lax
import numpy as np

D_MODEL = 1024
BATCH = 16
SEQ = 256
DEPTH = 1
DEC_BATCH = 4
DEC_SEQ = 1024
PAST_LEN = 512

GRID_W = 64
N_HEADS = 8
KV_HEADS = 2
Q_PER_KV = N_HEADS // KV_HEADS
HEAD_DIM = 64
ATTN_WIDTH = N_HEADS * HEAD_DIM
KV_WIDTH = KV_HEADS * HEAD_DIM
Q_BLOCK = 128
ROPE_THETA = 10000.0
ROPE_PAIRS = HEAD_DIM // 4
R_HEADS = 8
R_HEAD_DIM = 64
R_WIDTH = R_HEADS * R_HEAD_DIM
DECAY_RANK = 64
ICLR_RANK = 64
GATE_RANK = 128
R_IN_WIDTH = 3 * R_WIDTH + DECAY_RANK + ICLR_RANK + GATE_RANK
IN_WIDTH = ATTN_WIDTH + 2 * KV_WIDTH + R_IN_WIDTH + 2 * D_MODEL
D_FF = 2816
N_MOD = 6
NORM_EPS = 1e-6
GN_EPS = 64e-5
DECAY_OFFSET = 0.5

kernel_name = "hybrid_dit_attn_rwkv7_prefix_step"


def _rmsnorm(x, g):
    xf = x.astype(jnp.float32)
    y = xf * lax.rsqrt(jnp.mean(xf * xf, axis=-1, keepdims=True) + NORM_EPS)
    return (y * g.astype(jnp.float32)).astype(x.dtype)


def _modulate(h, shift, scale):
    return h * (1 + scale[:, None, :]) + shift[:, None, :]


def _dwconv3(x, w):
    xp = jnp.pad(x, ((0, 0), (1, 1), (0, 0)))
    return xp[:, :-2] * w[0] + xp[:, 1:-1] * w[1] + xp[:, 2:] * w[2]


def _axial_rope_tables(rows):
    row = jnp.repeat(jnp.arange(rows), GRID_W).astype(jnp.float32)
    col = jnp.tile(jnp.arange(GRID_W), rows).astype(jnp.float32)
    inv = 1.0 / (ROPE_THETA ** (jnp.arange(ROPE_PAIRS, dtype=jnp.float32) / ROPE_PAIRS))
    ang = jnp.concatenate([row[:, None] * inv, col[:, None] * inv], axis=-1)
    return jnp.cos(ang), jnp.sin(ang)


def _apply_rope(x, cos, sin):
    x1, x2 = jnp.split(x, 2, axis=-1)
    cos = cos.astype(x.dtype)
    sin = sin.astype(x.dtype)
    return jnp.concatenate([x1 * cos - x2 * sin, x2 * cos + x1 * sin], axis=-1)


def _block_attention(q, k, v):
    b, h, t, d = q.shape
    nb = t // Q_BLOCK
    qb = jnp.moveaxis(q.reshape(b, KV_HEADS, Q_PER_KV, nb, Q_BLOCK, d), 3, 0)
    scale = d ** -0.5

    def one_block(qblk):
        s = jnp.einsum("bkgqd,bkld->bkgql", qblk, k).astype(jnp.float32) * scale
        p = jax.nn.softmax(s, axis=-1).astype(v.dtype)
        return jnp.einsum("bkgql,bkld->bkgqd", p, v)

    o = lax.map(one_block, qb)
    o = jnp.moveaxis(o, 0, 3).reshape(b, h, t, d)
    return o.transpose(0, 2, 1, 3).reshape(b, t, h * d)


def _wkv7_scan(r, w, k, v, kk, a, s0, reverse):
    def step(s, inp):
        r_t, w_t, k_t, v_t, kk_t, a_t = inp
        sa = jnp.einsum("bhvk,bhk->bhv", s, -kk_t)
        s = (s * w_t[:, :, None, :] + sa[..., None] * (kk_t * a_t)[:, :, None, :]
             + v_t[..., None] * k_t[:, :, None, :])
        return s, jnp.einsum("bhvk,bhk->bhv", s, r_t)

    xs = tuple(jnp.moveaxis(z, 1, 0) for z in (r, w, k, v, kk, a))
    s_final, ys = lax.scan(step, s0, xs, reverse=reverse)
    return jnp.moveaxis(ys, 0, 1), s_final


def _rwkv7_bidir(u, p, s0):
    b, t, _ = u.shape
    f32 = jnp.float32
    u = _dwconv3(u, p["rwkv_conv"])
    splits = np.cumsum([R_WIDTH, R_WIDTH, R_WIDTH, DECAY_RANK, ICLR_RANK]).tolist()
    r, k, v, wd, ad, gd = jnp.split(u, splits, axis=-1)

    def heads(z):
        return z.reshape(b, t, R_HEADS, R_HEAD_DIM).astype(f32)

    rh, kh, vh = heads(r), heads(k), heads(v)
    kk = heads(k * p["rwkv_k_k"])
    kk = kk * lax.rsqrt(jnp.sum(kk * kk, axis=-1, keepdims=True) + 1e-12)
    ka = p["rwkv_k_a"].reshape(R_HEADS, R_HEAD_DIM).astype(f32)
    r_k = p["rwkv_r_k"].astype(f32)
    wd_t = jnp.tanh(wd)
    ys, bonus, finals = [], [], []
    for d, reverse in enumerate((False, True)):
        logw = -jax.nn.softplus(-(p["rwkv_w0"][d] + wd_t @ p["rwkv_w2"][d])) - DECAY_OFFSET
        w = jnp.exp(-jnp.exp(heads(logw)))
        a = jax.nn.sigmoid(heads(p["rwkv_a0"][d] + ad @ p["rwkv_a2"][d]))
        kd = kh * (1 + (a - 1) * ka)
        y, s_fin = _wkv7_scan(rh, w, kd, vh, kk, a, s0[:, d].astype(f32), reverse)
        ys.append(y)
        bonus.append(jnp.sum(rh * kd * r_k, axis=-1, keepdims=True) * vh)
        finals.append(s_fin)
    y = ys[0] + ys[1]
    mu = jnp.mean(y, axis=-1, keepdims=True)
    var = jnp.mean(jnp.square(y - mu), axis=-1, keepdims=True)
    y = ((y - mu) * lax.rsqrt(var + GN_EPS)).reshape(b, t, R_WIDTH)
    y = (y * p["rwkv_ln_g"].astype(f32) + p["rwkv_ln_b"].astype(f32)
         + (bonus[0] + bonus[1]).reshape(b, t, R_WIDTH))
    g = jax.nn.sigmoid(gd) @ p["rwkv_g2"]
    return y.astype(u.dtype) * g, jnp.stack(finals, axis=1)


def _layer(x, mod, p, rope, ctx_k, ctx_v, s0):
    b, t, _ = x.shape
    shift1, scale1, gate1, shift2, scale2, gate2 = jnp.split(mod, N_MOD, axis=-1)
    h = _modulate(_rmsnorm(x, p["norm1_g"]), shift1, scale1)
    proj = h @ p["w_in"]
    splits = np.cumsum([ATTN_WIDTH, KV_WIDTH, KV_WIDTH, R_IN_WIDTH, D_MODEL]).tolist()
    q, k, v, u, ga, gr = jnp.split(proj, splits, axis=-1)
    q = _rmsnorm(q.reshape(b, t, N_HEADS, HEAD_DIM), p["q_norm_g"]).transpose(0, 2, 1, 3)
    k = _rmsnorm(k.reshape(b, t, KV_HEADS, HEAD_DIM), p["k_norm_g"]).transpose(0, 2, 1, 3)
    v = v.reshape(b, t, KV_HEADS, HEAD_DIM).transpose(0, 2, 1, 3)
    if rope is None:
        keys, vals = k, v
    else:
        cos, sin = rope
        q = _apply_rope(q, cos, sin)
        keys = jnp.concatenate([_apply_rope(k, cos, sin), ctx_k.astype(k.dtype)], axis=2)
        vals = jnp.concatenate([v, ctx_v.astype(v.dtype)], axis=2)
    attn_o = _block_attention(q, keys, vals)
    rwkv_o, s_final = _rwkv7_bidir(u, p, s0)
    merged = (jax.nn.sigmoid(ga) * (attn_o @ p["w_attn_br"])
              + jax.nn.sigmoid(gr) * (rwkv_o @ p["w_rwkv_br"]))
    x = x + gate1[:, None, :] * (merged @ p["w_out"])
    h2 = _modulate(_rmsnorm(x, p["norm2_g"]), shift2, scale2)
    up = _dwconv3(h2 @ p["ffn_up"], p["ffn_conv"])
    up_u, up_g = jnp.split(up, 2, axis=-1)
    x = x + gate2[:, None, :] * ((jax.nn.silu(up_g) * up_u) @ p["ffn_down"])
    return x, k, v, s_final


def setup_inputs(seed: int = 0) -> dict:
    key = jax.random.key(seed)
    ks = jax.random.split(key, 40)
    nrm = jax.random.normal
    f32 = jnp.float32
    L = DEPTH
    conv_base = jnp.array([0.3, 1.0, 0.3], dtype=f32)[:, None]
    return {
        "x_prompt": nrm(ks[0], (BATCH, SEQ, D_MODEL), f32),
        "x_sample": nrm(ks[1], (DEC_BATCH, DEC_SEQ, D_MODEL), f32),
        "cache_k": nrm(ks[2], (DEC_BATCH, L, KV_HEADS, PAST_LEN, HEAD_DIM), f32),
        "cache_v": nrm(ks[3], (DEC_BATCH, L, KV_HEADS, PAST_LEN, HEAD_DIM), f32),
        "state_rwkv": 0.5 * nrm(ks[4], (DEC_BATCH, L, 2, R_HEADS, R_HEAD_DIM, R_HEAD_DIM), f32),
        "c": nrm(ks[5], (DEC_BATCH, D_MODEL), f32),
        "c_ctx": nrm(ks[6], (D_MODEL,), f32),
        "w_ada": 0.5 * D_MODEL ** -0.5 * nrm(ks[7], (L, D_MODEL, N_MOD * D_MODEL), f32),
        "b_ada": 0.02 * nrm(ks[8], (L, N_MOD * D_MODEL), f32),
        "norm1_g": 1.0 + 0.02 * nrm(ks[9], (L, D_MODEL), f32),
        "w_in": D_MODEL ** -0.5 * nrm(ks[10], (L, D_MODEL, IN_WIDTH), f32),
        "q_norm_g": 1.0 + 0.02 * nrm(ks[11], (L, HEAD_DIM), f32),
        "k_norm_g": 1.0 + 0.02 * nrm(ks[12], (L, HEAD_DIM), f32),
        "rwkv_conv": conv_base + 0.1 * nrm(ks[13], (L, 3, R_IN_WIDTH), f32),
        "rwkv_w0": 1.5 * nrm(ks[14], (L, 2, R_WIDTH), f32) - 1.5,
        "rwkv_w2": 0.5 * DECAY_RANK ** -0.5 * nrm(ks[15], (L, 2, DECAY_RANK, R_WIDTH), f32),
        "rwkv_a0": 0.5 * nrm(ks[16], (L, 2, R_WIDTH), f32),
        "rwkv_a2": 0.5 * ICLR_RANK ** -0.5 * nrm(ks[17], (L, 2, ICLR_RANK, R_WIDTH), f32),
        "rwkv_g2": GATE_RANK ** -0.5 * nrm(ks[18], (L, GATE_RANK, R_WIDTH), f32),
        "rwkv_k_k": 1.0 + 0.1 * nrm(ks[19], (L, R_WIDTH), f32),
        "rwkv_k_a": 1.0 + 0.1 * nrm(ks[20], (L, R_WIDTH), f32),
        "rwkv_r_k": 0.1 * nrm(ks[21], (L, R_HEADS, R_HEAD_DIM), f32),
        "rwkv_ln_g": 1.0 + 0.02 * nrm(ks[22], (L, R_WIDTH), f32),
        "rwkv_ln_b": 0.02 * nrm(ks[23], (L, R_WIDTH), f32),
        "w_attn_br": ATTN_WIDTH ** -0.5 * nrm(ks[24], (L, ATTN_WIDTH, D_MODEL), f32),
        "w_rwkv_br": R_WIDTH ** -0.5 * nrm(ks[25], (L, R_WIDTH, D_MODEL), f32),
        "w_out": D_MODEL ** -0.5 * nrm(ks[26], (L, D_MODEL, D_MODEL), f32),
        "norm2_g": 1.0 + 0.02 * nrm(ks[27], (L, D_MODEL), f32),
        "ffn_up": D_MODEL ** -0.5 * nrm(ks[28], (L, D_MODEL, 2 * D_FF), f32),
        "ffn_conv": conv_base + 0.1 * nrm(ks[29], (L, 3, 2 * D_FF), f32),
        "ffn_down": D_FF ** -0.5 * nrm(ks[30], (L, D_FF, D_MODEL), f32),
        "final_norm_g": 1.0 + 0.02 * nrm(ks[31], (D_MODEL,), f32),
    }


def reference(x_prompt, x_sample, cache_k, cache_v, state_rwkv, c, c_ctx,
              w_ada, b_ada, norm1_g, w_in, q_norm_g, k_norm_g, rwkv_conv,
              rwkv_w0, rwkv_w2, rwkv_a0, rwkv_a2, rwkv_g2, rwkv_k_k, rwkv_k_a,
              rwkv_r_k, rwkv_ln_g, rwkv_ln_b, w_attn_br, w_rwkv_br, w_out,
              norm2_g, ffn_up, ffn_conv, ffn_down, final_norm_g):
    rows = x_sample.shape[1] // GRID_W
    rope = _axial_rope_tables(rows)
    s_zero = jnp.zeros((x_prompt.shape[0], 2, R_HEADS, R_HEAD_DIM, R_HEAD_DIM), jnp.float32)
    xp, xs = x_prompt, x_sample
    new_k, new_v, new_s = [], [], []
    for l in range(DEPTH):
        p = {
            "norm1_g": norm1_g[l], "w_in": w_in[l], "q_norm_g": q_norm_g[l],
            "k_norm_g": k_norm_g[l], "rwkv_conv": rwkv_conv[l], "rwkv_w0": rwkv_w0[l],
            "rwkv_w2": rwkv_w2[l], "rwkv_a0": rwkv_a0[l], "rwkv_a2": rwkv_a2[l],
            "rwkv_g2": rwkv_g2[l], "rwkv_k_k": rwkv_k_k[l], "rwkv_k_a": rwkv_k_a[l],
            "rwkv_r_k": rwkv_r_k[l], "rwkv_ln_g": rwkv_ln_g[l], "rwkv_ln_b": rwkv_ln_b[l],
            "w_attn_br": w_attn_br[l], "w_rwkv_br": w_rwkv_br[l], "w_out": w_out[l],
            "norm2_g": norm2_g[l], "ffn_up": ffn_up[l], "ffn_conv": ffn_conv[l],
            "ffn_down": ffn_down[l],
        }
        mod_ctx = (jax.nn.silu(c_ctx) @ w_ada[l] + b_ada[l])[None, :]
        mod_lat = jax.nn.silu(c) @ w_ada[l] + b_ada[l]
        xp, k_ctx, v_ctx, s_ctx = _layer(xp, mod_ctx, p, None, None, None, s_zero)
        new_k.append(k_ctx)
        new_v.append(v_ctx)
        new_s.append(s_ctx)
        xs, _, _, _ = _layer(xs, mod_lat, p, rope, cache_k[:, l], cache_v[:, l], state_rwkv[:, l])
    y_prompt = _rmsnorm(xp, final_norm_g)
    y_sample = _rmsnorm(xs, final_norm_g)
    new_cache_k = jnp.stack(new_k, axis=1)
    new_cache_v = jnp.stack(new_v, axis=1)
    new_state_rwkv = jnp.stack(new_s, axis=1)
    return (y_prompt, y_sample, new_cache_k, new_cache_v, new_state_rwkv)
```

```cpp
#include <hip/hip_runtime.h>
#include <hip/hip_cooperative_groups.h>
#include <cstdio>
namespace cg = cooperative_groups;

#ifndef FUSED
#define FUSED 0
#endif

typedef unsigned short bf16_t;
typedef __attribute__((ext_vector_type(8))) short bf16x8;
typedef __attribute__((ext_vector_type(16))) float f32x16;
typedef __attribute__((ext_vector_type(2))) float f32x2;
typedef __attribute__((ext_vector_type(2))) __bf16 bf16x2_t;

#define DI __device__ __forceinline__
#define MFMA(a, b, c) __builtin_amdgcn_mfma_f32_32x32x16_bf16((a), (b), (c), 0, 0, 0)

#define NTOK 8192
#define QSCALE 0.18033688011112042f

struct Params {
  const float *x_prompt, *x_sample, *cache_k, *cache_v, *state, *c, *c_ctx, *w_ada, *b_ada, *norm1_g, *w_in,
      *q_norm_g, *k_norm_g, *rwkv_conv, *w0, *w2, *a0, *a2, *g2, *k_k, *k_a, *r_k, *ln_g, *ln_b, *w_attn_br,
      *w_rwkv_br, *w_out, *norm2_g, *ffn_up, *ffn_conv, *ffn_down, *final_g;
  float* out;
  float* mod;
  bf16_t *wt_in, *wt_attn, *wt_rwkv, *wt_out, *wt_up, *wt_down, *wt_w2, *wt_a2, *wt_g2;
  bf16_t* h;
  bf16_t *attn_o, *rwkv_o;
  bf16_t* projA;
  bf16_t* gates;
  float* Y;
  bf16_t* act;
  bf16_t* SH;
  float* DW;
  bf16_t* DK;
  bf16_t* up;
  bf16_t* gbuf;
  float* BS;
  bf16_t* q;
  bf16_t *Kc, *Kl, *Vtc, *Vtl;
  bf16_t* merged;
};

DI unsigned pack2(float a, float b) {
  f32x2 v = {a, b};
  bf16x2_t r = __builtin_convertvector(v, bf16x2_t);
  return __builtin_bit_cast(unsigned, r);
}
DI bf16_t f2bf(float a) { return (bf16_t)(pack2(a, 0.f) & 0xffffu); }
DI float bflo(unsigned u) { return __uint_as_float(u << 16); }
DI float bfhi(unsigned u) { return __uint_as_float(u & 0xffff0000u); }
DI float bf2f(bf16_t b) { return __uint_as_float(((unsigned)b) << 16); }

template <int CTRL> DI float dppf(float x) {
  return __int_as_float(__builtin_amdgcn_update_dpp(0, __float_as_int(x), CTRL, 0xF, 0xF, true));
}
DI float red8(float x) {
  x += dppf<0xB1>(x);
  x += dppf<0x4E>(x);
  x += dppf<0x141>(x);
  return x;
}
DI float wave_sum(float x) {
#pragma unroll
  for (int o = 32; o >= 1; o >>= 1) x += __shfl_xor(x, o);
  return x;
}
DI const float* xrow(const Params& p, int tok) {
  return tok < 4096 ? p.x_prompt + (size_t)tok * 1024 : p.x_sample + (size_t)(tok - 4096) * 1024;
}
DI int modrow(int tok) { return tok < 4096 ? 0 : 1 + ((tok - 4096) >> 10); }
DI float sigmoidf_(float x) { return 1.f / (1.f + __expf(-x)); }

DI void transpose_tile(const float* __restrict__ W, bf16_t* __restrict__ Wt, int K, int N, int tile, char* smem) {
  const int tid = threadIdx.x;
  const int ntn = N >> 6;
  const int tk = tile / ntn, tn = tile - tk * ntn;
  const int k0 = tk * 64, n0 = tn * 64;
  float* t = (float*)smem;
  const int tx = tid & 15, ty = tid >> 4;
#pragma unroll
  for (int i = 0; i < 4; ++i) {
    int k = ty + 16 * i;
    float4 v = *(const float4*)(W + (size_t)(k0 + k) * N + n0 + tx * 4);
    t[k * 65 + tx * 4 + 0] = v.x; t[k * 65 + tx * 4 + 1] = v.y; t[k * 65 + tx * 4 + 2] = v.z; t[k * 65 + tx * 4 + 3] = v.w;
  }
  __syncthreads();
  const int n = tid >> 2, kc = tid & 3;
  unsigned o[8];
#pragma unroll
  for (int j = 0; j < 8; ++j) o[j] = pack2(t[(kc * 16 + 2 * j) * 65 + n], t[(kc * 16 + 2 * j + 1) * 65 + n]);
  uint4* dst = (uint4*)(Wt + (size_t)(n0 + n) * K + k0 + kc * 16);
  dst[0] = make_uint4(o[0], o[1], o[2], o[3]);
  dst[1] = make_uint4(o[4], o[5], o[6], o[7]);
  __syncthreads();
}

#define P0_MOD_UNITS 192
#define P0_UNITS (192 + 1152 + 128 + 128 + 256 + 1408 + 704 + 16 + 16 + 16)
DI void phase0(const Params& p, int u, char* smem) {
  const int tid = threadIdx.x;
  if (u < P0_MOD_UNITS) {
    float* sc = (float*)smem;
    float* red = sc + 5 * 1024;
    for (int i = tid; i < 5 * 1024; i += 256) {
      int r = i >> 10, k = i & 1023;
      float cv = (r == 0) ? p.c_ctx[k] : p.c[(r - 1) * 1024 + k];
      sc[i] = cv / (1.f + __expf(-cv));
    }
    __syncthreads();
    const int cgp = tid & 7, kg = tid >> 3;
    const int n = u * 32 + cgp * 4;
    float4 acc[5];
#pragma unroll
    for (int r = 0; r < 5; ++r) acc[r] = make_float4(0.f, 0.f, 0.f, 0.f);
#pragma unroll 4
    for (int kk = 0; kk < 32; ++kk) {
      int k = kg * 32 + kk;
      float4 w = *(const float4*)(p.w_ada + (size_t)k * 6144 + n);
#pragma unroll
      for (int r = 0; r < 5; ++r) {
        float s = sc[r * 1024 + k];
        acc[r].x += s * w.x; acc[r].y += s * w.y; acc[r].z += s * w.z; acc[r].w += s * w.w;
      }
    }
#pragma unroll
    for (int r = 0; r < 5; ++r) {
      float* d = red + (kg * 5 + r) * 32 + cgp * 4;
      d[0] = acc[r].x; d[1] = acc[r].y; d[2] = acc[r].z; d[3] = acc[r].w;
    }
    __syncthreads();
    if (tid < 160) {
      int r = tid >> 5, ci = tid & 31;
      float s = p.b_ada[u * 32 + ci];
      for (int g = 0; g < 32; ++g) s += red[(g * 5 + r) * 32 + ci];
      p.mod[r * 6144 + u * 32 + ci] = s;
    }
    __syncthreads();
    return;
  }
  int t = u - P0_MOD_UNITS;
  if (t < 1152) { transpose_tile(p.w_in, p.wt_in, 1024, 4608, t, smem); return; }
  t -= 1152;
  if (t < 128) { transpose_tile(p.w_attn_br, p.wt_attn, 512, 1024, t, smem); return; }
  t -= 128;
  if (t < 128) { transpose_tile(p.w_rwkv_br, p.wt_rwkv, 512, 1024, t, smem); return; }
  t -= 128;
  if (t < 256) { transpose_tile(p.w_out, p.wt_out, 1024, 1024, t, smem); return; }
  t -= 256;
  if (t < 1408) { transpose_tile(p.ffn_up, p.wt_up, 1024, 5632, t, smem); return; }
  t -= 1408;
  if (t < 704) { transpose_tile(p.ffn_down, p.wt_down, 2816, 1024, t, smem); return; }
  t -= 704;
  if (t < 16) { int d = t >> 3; transpose_tile(p.w2 + d * 64 * 512, p.wt_w2 + d * 512 * 64, 64, 512, t & 7, smem); return; }
  t -= 16;
  if (t < 16) { int d = t >> 3; transpose_tile(p.a2 + d * 64 * 512, p.wt_a2 + d * 512 * 64, 64, 512, t & 7, smem); return; }
  t -= 16;
  transpose_tile(p.g2, p.wt_g2, 128, 512, t, smem);
}

template <int MODE> DI void norm_rows(const Params& p, int u) {
  const int tid = threadIdx.x, wave = tid >> 6, lane = tid & 63;
  const int tok = u * 4 + wave;
  const float* xr = (MODE == 0) ? xrow(p, tok) : p.out + (size_t)tok * 1024;
  float4 v[4];
  float ss = 0.f;
#pragma unroll
  for (int i = 0; i < 4; ++i) {
    v[i] = *(const float4*)(xr + lane * 4 + 256 * i);
    ss += v[i].x * v[i].x + v[i].y * v[i].y + v[i].z * v[i].z + v[i].w * v[i].w;
  }
  ss = wave_sum(ss);
  const float rstd = rsqrtf(ss * (1.f / 1024.f) + 1e-6f);
  const float* g = (MODE == 0) ? p.norm1_g : (MODE == 1) ? p.norm2_g : p.final_g;
  const float* mr = p.mod + modrow(tok) * 6144 + (MODE == 1 ? 3 * 1024 : 0);
#pragma unroll
  for (int i = 0; i < 4; ++i) {
    int c = lane * 4 + 256 * i;
    float4 gg = *(const float4*)(g + c);
    float y0 = v[i].x * rstd * gg.x, y1 = v[i].y * rstd * gg.y, y2 = v[i].z * rstd * gg.z, y3 = v[i].w * rstd * gg.w;
    if (MODE < 2) {
      float4 sh = *(const float4*)(mr + c);
      float4 scl = *(const float4*)(mr + 1024 + c);
      y0 = y0 * (1.f + scl.x) + sh.x; y1 = y1 * (1.f + scl.y) + sh.y; y2 = y2 * (1.f + scl.z) + sh.z; y3 = y3 * (1.f + scl.w) + sh.w;
      *(uint2*)(p.h + (size_t)tok * 1024 + c) = make_uint2(pack2(y0, y1), pack2(y2, y3));
    } else {
      *(float4*)(p.out + (size_t)tok * 1024 + c) = make_float4(y0, y1, y2, y3);
    }
  }
}

DI void gemm_mainloop(f32x16 (&acc)[2][2], const bf16_t* __restrict__ A, int lda, const bf16_t* __restrict__ Bt, int ldb, int K, char* smem) {
  const int tid = threadIdx.x, lane = tid & 63, wave = tid >> 6;
  const int wm = wave >> 1, wn = wave & 1;
  const int lr = tid >> 3, lc = tid & 7;
  uint4 ra[4], rb[4];
  const bf16_t* ap = A + (size_t)lr * lda + lc * 8;
  const bf16_t* bp = Bt + (size_t)lr * ldb + lc * 8;
  const int woff = lr * 128 + ((lc ^ (lr & 7)) << 4);
#pragma unroll
  for (int i = 0; i < 4; ++i) {
    ra[i] = *(const uint4*)(ap + (size_t)(32 * i) * lda);
    rb[i] = *(const uint4*)(bp + (size_t)(32 * i) * ldb);
  }
#pragma unroll
  for (int i = 0; i < 4; ++i) {
    *(uint4*)(smem + woff + i * 4096) = ra[i];
    *(uint4*)(smem + 16384 + woff + i * 4096) = rb[i];
  }
  __syncthreads();
  const int nk = K >> 6;
  const int l31 = lane & 31, hh = lane >> 5, l7 = lane & 7;
  for (int kt = 0; kt < nk; ++kt) {
    const bool more = (kt + 1 < nk);
    if (more) {
      const int k0 = (kt + 1) * 64;
#pragma unroll
      for (int i = 0; i < 4; ++i) {
        ra[i] = *(const uint4*)(ap + (size_t)(32 * i) * lda + k0);
        rb[i] = *(const uint4*)(bp + (size_t)(32 * i) * ldb + k0);
      }
    }
    const char* as = smem + (kt & 1) * 32768;
    const char* bs = as + 16384;
#pragma unroll
    for (int ks = 0; ks < 4; ++ks) {
      bf16x8 af[2], bfr[2];
      const int ch = ((ks * 2 + hh) ^ l7) << 4;
#pragma unroll
      for (int i = 0; i < 2; ++i) af[i] = *(const bf16x8*)(as + (wm * 64 + i * 32 + l31) * 128 + ch);
#pragma unroll
      for (int j = 0; j < 2; ++j) bfr[j] = *(const bf16x8*)(bs + (wn * 64 + j * 32 + l31) * 128 + ch);
#pragma unroll
      for (int i = 0; i < 2; ++i)
#pragma unroll
        for (int j = 0; j < 2; ++j) acc[i][j] = MFMA(af[i], bfr[j], acc[i][j]);
    }
    if (more) {
      char* ws = smem + ((kt + 1) & 1) * 32768;
#pragma unroll
      for (int i = 0; i < 4; ++i) {
        *(uint4*)(ws + woff + i * 4096) = ra[i];
        *(uint4*)(ws + 16384 + woff + i * 4096) = rb[i];
      }
    }
    __syncthreads();
  }
}

DI void zero_acc(f32x16 (&acc)[2][2]) {
#pragma unroll
  for (int i = 0; i < 2; ++i)
#pragma unroll
    for (int j = 0; j < 2; ++j)
#pragma unroll
      for (int r = 0; r < 16; ++r) acc[i][j][r] = 0.f;
}

template <int EPI> DI void gemm_unit(const Params& p, int u, char* smem) {
  const int mt = u & 63, nt = u >> 6;
  const int m0 = mt * 128, n0 = nt * 128;
  const int tid = threadIdx.x, lane = tid & 63, wave = tid >> 6;
  const int wm = wave >> 1, wn = wave & 1, l31 = lane & 31, hh = lane >> 5;
  f32x16 acc[2][2];
  zero_acc(acc);
  if (EPI == 0) gemm_mainloop(acc, p.h + (size_t)m0 * 1024, 1024, p.wt_in + (size_t)n0 * 1024, 1024, 1024, smem);
  if (EPI == 1) gemm_mainloop(acc, p.attn_o + (size_t)m0 * 512, 512, p.wt_attn + (size_t)n0 * 512, 512, 512, smem);
  if (EPI == 2) gemm_mainloop(acc, p.merged + (size_t)m0 * 1024, 1024, p.wt_out + (size_t)n0 * 1024, 1024, 1024, smem);
  if (EPI == 3) gemm_mainloop(acc, p.h + (size_t)m0 * 1024, 1024, p.wt_up + (size_t)n0 * 1024, 1024, 1024, smem);
  if (EPI == 4) gemm_mainloop(acc, p.act + (size_t)m0 * 2816, 2816, p.wt_down + (size_t)n0 * 2816, 2816, 2816, smem);
  if (EPI == 1) {
#pragma unroll
    for (int i = 0; i < 2; ++i)
#pragma unroll
      for (int j = 0; j < 2; ++j)
#pragma unroll
        for (int r = 0; r < 16; ++r) {
          int m = m0 + wm * 64 + i * 32 + (r & 3) + 8 * (r >> 2) + 4 * hh;
          int n = n0 + wn * 64 + j * 32 + l31;
          float ga = bf2f(p.gates[(size_t)m * 2048 + n]);
          float gr = bf2f(p.gates[(size_t)m * 2048 + 1024 + n]);
          acc[i][j][r] *= (1.f + __expf(-gr)) / (1.f + __expf(-ga));
        }
    gemm_mainloop(acc, p.rwkv_o + (size_t)m0 * 512, 512, p.wt_rwkv + (size_t)n0 * 512, 512, 512, smem);
  }
#pragma unroll
  for (int i = 0; i < 2; ++i)
#pragma unroll
    for (int j = 0; j < 2; ++j)
#pragma unroll
      for (int r = 0; r < 16; ++r) {
        const int m = m0 + wm * 64 + i * 32 + (r & 3) + 8 * (r >> 2) + 4 * hh;
        const int n = n0 + wn * 64 + j * 32 + l31;
        const float a = acc[i][j][r];
        if (EPI == 0) {
          if (n0 < 2560) p.projA[(size_t)m * 2560 + n] = f2bf(a);
          else p.gates[(size_t)m * 2048 + (n - 2560)] = f2bf(a);
        } else if (EPI == 1) {
          float gr = bf2f(p.gates[(size_t)m * 2048 + 1024 + n]);
          p.merged[(size_t)m * 1024 + n] = f2bf(a * sigmoidf_(gr));
        } else if (EPI == 2) {
          float g1 = p.mod[modrow(m) * 6144 + 2 * 1024 + n];
          p.out[(size_t)m * 1024 + n] = xrow(p, m)[n] + g1 * a;
        } else if (EPI == 3) {
          p.up[(size_t)m * 5632 + n] = f2bf(a);
        } else {
          float g2 = p.mod[modrow(m) * 6144 + 5 * 1024 + n];
          float* o = p.out + (size_t)m * 1024 + n;
          *o = *o + g2 * a;
        }
      }
}

DI void load4bf(const bf16_t* p, float (&o)[4]) {
  uint2 v = *(const uint2*)p;
  o[0] = bflo(v.x); o[1] = bfhi(v.x); o[2] = bflo(v.y); o[3] = bfhi(v.y);
}
DI void attn_prep_token(const Params& p, int tok) {
  const int lane = threadIdx.x & 63;
  const int sub = lane & 7;
  const bool latent = tok >= 4096;
  int s, t, L;
  if (!latent) { s = tok >> 8; t = tok & 255; L = 256; }
  else { s = (tok - 4096) >> 10; t = (tok - 4096) & 1023; L = 1024; }
  const bf16_t* pr = p.projA + (size_t)tok * 2560;
  float cs[4], sn[4];
  if (latent) {
    const int row = t >> 6, col = t & 63;
#pragma unroll
    for (int i = 0; i < 4; ++i) {
      int pi = sub * 4 + i;
      float inv = 1.0f / powf(10000.f, (float)(pi & 15) * (1.f / 16.f));
      float ang = (pi < 16 ? (float)row : (float)col) * inv;
      sincosf(ang, &sn[i], &cs[i]);
    }
  }
  {
    const int hd = lane >> 3;
    float lo[4], hi[4];
    load4bf(pr + hd * 64 + sub * 4, lo);
    load4bf(pr + hd * 64 + 32 + sub * 4, hi);
    float ss = 0.f;
#pragma unroll
    for (int i = 0; i < 4; ++i) ss += lo[i] * lo[i] + hi[i] * hi[i];
    ss = red8(ss);
    const float rinv = rsqrtf(ss * (1.f / 64.f) + 1e-6f);
    float4 gl = *(const float4*)(p.q_norm_g + sub * 4), gh = *(const float4*)(p.q_norm_g + 32 + sub * 4);
    const float glv[4] = {gl.x, gl.y, gl.z, gl.w}, ghv[4] = {gh.x, gh.y, gh.z, gh.w};
#pragma unroll
    for (int i = 0; i < 4; ++i) {
      float a = lo[i] * rinv * glv[i], b = hi[i] * rinv * ghv[i];
      if (latent) { float na = a * cs[i] - b * sn[i]; float nb = b * cs[i] + a * sn[i]; a = na; b = nb; }
      lo[i] = a * QSCALE; hi[i] = b * QSCALE;
    }
    size_t qo = latent ? (size_t)4096 * 512 + ((size_t)(s * 8 + hd) * 1024 + t) * 64 : ((size_t)(s * 8 + hd) * 256 + t) * 64;
    *(uint2*)(p.q + qo + sub * 4) = make_uint2(pack2(lo[0], lo[1]), pack2(lo[2], lo[3]));
    *(uint2*)(p.q + qo + 32 + sub * 4) = make_uint2(pack2(hi[0], hi[1]), pack2(hi[2], hi[3]));
  }
  {
    const int kvh = (lane >> 3) & 1;
    float lo[4], hi[4];
    load4bf(pr + 512 + kvh * 64 + sub * 4, lo);
    load4bf(pr + 512 + kvh * 64 + 32 + sub * 4, hi);
    float ss = 0.f;
#pragma unroll
    for (int i = 0; i < 4; ++i) ss += lo[i] * lo[i] + hi[i] * hi[i];
    ss = red8(ss);
    const float rinv = rsqrtf(ss * (1.f / 64.f) + 1e-6f);
    float4 gl = *(const float4*)(p.k_norm_g + sub * 4), gh = *(const float4*)(p.k_norm_g + 32 + sub * 4);
    const float glv[4] = {gl.x, gl.y, gl.z, gl.w}, ghv[4] = {gh.x, gh.y, gh.z, gh.w};
#pragma unroll
    for (int i = 0; i < 4; ++i) { lo[i] = lo[i] * rinv * glv[i]; hi[i] = hi[i] * rinv * ghv[i]; }
    if (lane < 16) {
      if (!latent) {
        float* ok = p.out + (size_t)2 * 4194304 + ((size_t)(s * 2 + kvh) * 256 + t) * 64;
        *(float4*)(ok + sub * 4) = make_float4(lo[0], lo[1], lo[2], lo[3]);
        *(float4*)(ok + 32 + sub * 4) = make_float4(hi[0], hi[1], hi[2], hi[3]);
        bf16_t* kb = p.Kc + ((size_t)(s * 2 + kvh) * 256 + t) * 64;
        *(uint2*)(kb + sub * 4) = make_uint2(pack2(lo[0], lo[1]), pack2(lo[2], lo[3]));
        *(uint2*)(kb + 32 + sub * 4) = make_uint2(pack2(hi[0], hi[1]), pack2(hi[2], hi[3]));
      } else {
#pragma unroll
        for (int i = 0; i < 4; ++i) {
          float a = lo[i], b = hi[i];
          lo[i] = a * cs[i] - b * sn[i]; hi[i] = b * cs[i] + a * sn[i];
        }
        bf16_t* kb = p.Kl + ((size_t)(s * 2 + kvh) * 1536 + t) * 64;
        *(uint2*)(kb + sub * 4) = make_uint2(pack2(lo[0], lo[1]), pack2(lo[2], lo[3]));
        *(uint2*)(kb + 32 + sub * 4) = make_uint2(pack2(hi[0], hi[1]), pack2(hi[2], hi[3]));
      }
    }
  }
  if (lane >= 16 && lane < 32) {
    const int kvh = (lane >> 3) & 1;
    float lo[4], hi[4];
    load4bf(pr + 640 + kvh * 64 + sub * 4, lo);
    load4bf(pr + 640 + kvh * 64 + 32 + sub * 4, hi);
    bf16_t* vt;
    int LK;
    if (!latent) {
      float* ov = p.out + (size_t)2 * 4194304 + 524288 + ((size_t)(s * 2 + kvh) * 256 + t) * 64;
      *(float4*)(ov + sub * 4) = make_float4(lo[0], lo[1], lo[2], lo[3]);
      *(float4*)(ov + 32 + sub * 4) = make_float4(hi[0], hi[1], hi[2], hi[3]);
      vt = p.Vtc + (size_t)(s * 2 + kvh) * 64 * 256 + t; LK = 256;
    } else {
      vt = p.Vtl + (size_t)(s * 2 + kvh) * 64 * 1536 + t; LK = 1536;
    }
#pragma unroll
    for (int i = 0; i < 4; ++i) {
      vt[(size_t)(sub * 4 + i) * LK] = f2bf(lo[i]);
      vt[(size_t)(32 + sub * 4 + i) * LK] = f2bf(hi[i]);
    }
  }
  (void)L;
}

DI void cache_conv_unit(const Params& p, int u, char* smem) {
  const int tid = threadIdx.x;
  const int kb = u & 7, bk = u >> 3;
  const float* ck = p.cache_k + ((size_t)bk * 512 + kb * 64) * 64;
  const float* cv = p.cache_v + ((size_t)bk * 512 + kb * 64) * 64;
  float* t = (float*)smem;
  const int tx = tid & 15, ty = tid >> 4;
#pragma unroll
  for (int i = 0; i < 4; ++i) {
    int key = ty + 16 * i;
    float4 kv = *(const float4*)(ck + key * 64 + tx * 4);
    *(uint2*)(p.Kl + ((size_t)bk * 1536 + 1024 + kb * 64 + key) * 64 + tx * 4) = make_uint2(pack2(kv.x, kv.y), pack2(kv.z, kv.w));
    float4 v = *(const float4*)(cv + key * 64 + tx * 4);
    t[key * 65 + tx * 4 + 0] = v.x; t[key * 65 + tx * 4 + 1] = v.y; t[key * 65 + tx * 4 + 2] = v.z; t[key * 65 + tx * 4 + 3] = v.w;
  }
  __syncthreads();
  const int d = tid >> 2, kc = tid & 3;
  unsigned o[8];
#pragma unroll
  for (int j = 0; j < 8; ++j) o[j] = pack2(t[(kc * 16 + 2 * j) * 65 + d], t[(kc * 16 + 2 * j + 1) * 65 + d]);
  uint4* dst = (uint4*)(p.Vtl + ((size_t)bk * 64 + d) * 1536 + 1024 + kb * 64 + kc * 16);
  dst[0] = make_uint4(o[0], o[1], o[2], o[3]);
  dst[1] = make_uint4(o[4], o[5], o[6], o[7]);
  __syncthreads();
}

#define ACT_STRIDE 528
DI void conv4(const bf16_t* base, int col, bool hasp, bool hasn, const float* cw, int cwcol, float (&o)[4]) {
  float c0[4], c1[4], c2[4];
  load4bf(base + col, c1);
  if (hasp) load4bf(base - 2560 + col, c0); else { c0[0] = c0[1] = c0[2] = c0[3] = 0.f; }
  if (hasn) load4bf(base + 2560 + col, c2); else { c2[0] = c2[1] = c2[2] = c2[3] = 0.f; }
  float4 w0 = *(const float4*)(cw + cwcol), w1 = *(const float4*)(cw + 1792 + cwcol), w2 = *(const float4*)(cw + 2 * 1792 + cwcol);
  o[0] = c0[0] * w0.x + c1[0] * w1.x + c2[0] * w2.x;
  o[1] = c0[1] * w0.y + c1[1] * w1.y + c2[1] * w2.y;
  o[2] = c0[2] * w0.z + c1[2] * w1.z + c2[2] * w2.z;
  o[3] = c0[3] * w0.w + c1[3] * w1.w + c2[3] * w2.w;
}

DI void rwkv_prep_unit(const Params& p, int u, char* smem) {
  const int tid = threadIdx.x, lane = tid & 63, wave = tid >> 6;
  const int tile = u >> 1, hg = u & 1;
  const int tok0 = tile * 32;
  int seq_start, L;
  if (tok0 < 4096) { seq_start = tok0 & ~255; L = 256; } else { seq_start = 4096 + ((tok0 - 4096) & ~1023); L = 1024; }
  {
    const int col = tid;
    const int pc = 2304 + col;
    const float w0 = p.rwkv_conv[1536 + col], w1 = p.rwkv_conv[1792 + 1536 + col], w2 = p.rwkv_conv[2 * 1792 + 1536 + col];
    float prev = (tok0 > seq_start) ? bf2f(p.projA[(size_t)(tok0 - 1) * 2560 + pc]) : 0.f;
    float cur = bf2f(p.projA[(size_t)tok0 * 2560 + pc]);
    for (int i = 0; i < 32; ++i) {
      int tk = tok0 + i;
      float nxt = (tk + 1 < seq_start + L) ? bf2f(p.projA[(size_t)(tk + 1) * 2560 + pc]) : 0.f;
      float v = prev * w0 + cur * w1 + nxt * w2;
      if (col < 64) v = tanhf(v);
      else if (col >= 128) v = sigmoidf_(v);
      *(bf16_t*)(smem + i * ACT_STRIDE + col * 2) = f2bf(v);
      prev = cur; cur = nxt;
    }
  }
  __syncthreads();
  const int hd = hg * 4 + wave;
  const int n = lane & 31, hh = lane >> 5;
  const int tok = tok0 + n;
  const bool hasp = tok > seq_start, hasn = tok + 1 < seq_start + L;
  const bf16_t* pb = p.projA + (size_t)tok * 2560;
  const char* actrow = smem + n * ACT_STRIDE;
  float ss = 0.f;
#pragma unroll 1
  for (int tl = 0; tl < 2; ++tl)
#pragma unroll 2
    for (int g = 0; g < 4; ++g) {
      int c64 = tl * 32 + 8 * g + 4 * hh;
      int ch = hd * 64 + c64;
      float kc[4];
      conv4(pb, 768 + 512 + ch, hasp, hasn, p.rwkv_conv, 512 + ch, kc);
      float4 kkw = *(const float4*)(p.k_k + ch);
      float a0 = kc[0] * kkw.x, a1 = kc[1] * kkw.y, a2 = kc[2] * kkw.z, a3 = kc[3] * kkw.w;
      ss += a0 * a0 + a1 * a1 + a2 * a2 + a3 * a3;
    }
  ss += __shfl_xor(ss, 32);
  const float kkinv = rsqrtf(ss + 1e-12f);
  {
    f32x16 ag[2];
#pragma unroll
    for (int tl = 0; tl < 2; ++tl)
#pragma unroll
      for (int r = 0; r < 16; ++r) ag[tl][r] = 0.f;
#pragma unroll
    for (int ks = 0; ks < 8; ++ks) {
      bf16x8 bfr = *(const bf16x8*)(actrow + (128 + ks * 16 + hh * 8) * 2);
#pragma unroll
      for (int tl = 0; tl < 2; ++tl) {
        bf16x8 af = *(const bf16x8*)(p.wt_g2 + (size_t)(hd * 64 + tl * 32 + n) * 128 + ks * 16 + hh * 8);
        ag[tl] = MFMA(af, bfr, ag[tl]);
      }
    }
#pragma unroll
    for (int tl = 0; tl < 2; ++tl)
#pragma unroll
      for (int g = 0; g < 4; ++g) {
        int ch = hd * 64 + tl * 32 + 8 * g + 4 * hh;
        *(uint2*)(p.gbuf + (size_t)tok * 512 + ch) = make_uint2(pack2(ag[tl][4 * g], ag[tl][4 * g + 1]), pack2(ag[tl][4 * g + 2], ag[tl][4 * g + 3]));
      }
  }
  float bs0 = 0.f, bs1 = 0.f;
#pragma unroll 1
  for (int tl = 0; tl < 2; ++tl) {
    float rc[16], kc[16], kk[16];
#pragma unroll
    for (int g = 0; g < 4; ++g) {
      int c64 = tl * 32 + 8 * g + 4 * hh;
      int ch = hd * 64 + c64;
      float r4[4], k4[4], v4[4];
      conv4(pb, 768 + ch, hasp, hasn, p.rwkv_conv, ch, r4);
      conv4(pb, 768 + 512 + ch, hasp, hasn, p.rwkv_conv, 512 + ch, k4);
      conv4(pb, 768 + 1024 + ch, hasp, hasn, p.rwkv_conv, 1024 + ch, v4);
      float4 kkw = *(const float4*)(p.k_k + ch);
      const float kkwv[4] = {kkw.x, kkw.y, kkw.z, kkw.w};
#pragma unroll
      for (int i = 0; i < 4; ++i) { rc[4 * g + i] = r4[i]; kc[4 * g + i] = k4[i]; kk[4 * g + i] = k4[i] * kkwv[i] * kkinv; }
      bf16_t* sh = p.SH + ((size_t)tok * 8 + hd) * 192 + c64;
      *(uint2*)(sh) = make_uint2(pack2(r4[0], r4[1]), pack2(r4[2], r4[3]));
      *(uint2*)(sh + 64) = make_uint2(pack2(v4[0], v4[1]), pack2(v4[2], v4[3]));
      *(uint2*)(sh + 128) = make_uint2(pack2(kk[4 * g], kk[4 * g + 1]), pack2(kk[4 * g + 2], kk[4 * g + 3]));
    }
#pragma unroll 1
    for (int d = 0; d < 2; ++d) {
      f32x16 aw, aa;
#pragma unroll
      for (int r = 0; r < 16; ++r) { aw[r] = 0.f; aa[r] = 0.f; }
#pragma unroll
      for (int ks = 0; ks < 4; ++ks) {
        bf16x8 bw = *(const bf16x8*)(actrow + (ks * 16 + hh * 8) * 2);
        bf16x8 ba = *(const bf16x8*)(actrow + (64 + ks * 16 + hh * 8) * 2);
        bf16x8 fw = *(const bf16x8*)(p.wt_w2 + (size_t)(d * 512 + hd * 64 + tl * 32 + n) * 64 + ks * 16 + hh * 8);
        bf16x8 fa = *(const bf16x8*)(p.wt_a2 + (size_t)(d * 512 + hd * 64 + tl * 32 + n) * 64 + ks * 16 + hh * 8);
        aw = MFMA(fw, bw, aw);
        aa = MFMA(fa, ba, aa);
      }
      float bsum = 0.f;
#pragma unroll
      for (int g = 0; g < 4; ++g) {
        int c64 = tl * 32 + 8 * g + 4 * hh;
        int ch = hd * 64 + c64;
        float4 w0v = *(const float4*)(p.w0 + d * 512 + ch);
        float4 a0v = *(const float4*)(p.a0 + d * 512 + ch);
        float4 kav = *(const float4*)(p.k_a + ch);
        float4 rkv = *(const float4*)(p.r_k + ch);
        const float w0a[4] = {w0v.x, w0v.y, w0v.z, w0v.w}, a0a[4] = {a0v.x, a0v.y, a0v.z, a0v.w};
        const float kaa[4] = {kav.x, kav.y, kav.z, kav.w}, rka[4] = {rkv.x, rkv.y, rkv.z, rkv.w};
        float wv[4], kdv[4], bv[4];
#pragma unroll
        for (int i = 0; i < 4; ++i) {
          int r = 4 * g + i;
          float xw = w0a[i] + aw[r];
          float z = -xw;
          float sp = fmaxf(z, 0.f) + log1pf(__expf(-fabsf(z)));
          float logw = -sp - 0.5f;
          wv[i] = __expf(-__expf(logw));
          float a = sigmoidf_(a0a[i] + aa[r]);
          kdv[i] = kc[r] * (1.f + (a - 1.f) * kaa[i]);
          bv[i] = kk[r] * a;
          bsum += rc[r] * kdv[i] * rka[i];
        }
        *(float4*)(p.DW + ((size_t)d * NTOK + tok) * 512 + ch) = make_float4(wv[0], wv[1], wv[2], wv[3]);
        bf16_t* dk = p.DK + (((size_t)d * NTOK + tok) * 8 + hd) * 128 + c64;
        *(uint2*)(dk) = make_uint2(pack2(kdv[0], kdv[1]), pack2(kdv[2], kdv[3]));
        *(uint2*)(dk + 64) = make_uint2(pack2(bv[0], bv[1]), pack2(bv[2], bv[3]));
      }
      if (d == 0) bs0 += bsum; else bs1 += bsum;
    }
  }
  bs0 += __shfl_xor(bs0, 32);
  bs1 += __shfl_xor(bs1, 32);
  if (hh == 0) *(float2*)(p.BS + ((size_t)tok * 8 + hd) * 2) = make_float2(bs0, bs1);
  __syncthreads();
}

#define SCH 16
DI void scan_unit(const Params& p, int tok0, int L, int hd, int d, int rh, const float* s0, float* sout, char* smem) {
  const int tid = threadIdx.x;
  const int row = rh * 32 + (tid >> 3), seg = tid & 7;
  float S[8];
  if (s0) {
    float4 a = *(const float4*)(s0 + row * 64 + seg * 8), b = *(const float4*)(s0 + row * 64 + seg * 8 + 4);
    S[0] = a.x; S[1] = a.y; S[2] = a.z; S[3] = a.w; S[4] = b.x; S[5] = b.y; S[6] = b.z; S[7] = b.w;
  } else {
#pragma unroll
    for (int j = 0; j < 8; ++j) S[j] = 0.f;
  }
  float* buf = (float*)smem;
  const int nchunk = L / SCH;
  const int sA_jt = tid / 24, sA_c = tid - sA_jt * 24;
  const int sB_id = 256 + tid, sB_jt = sB_id / 24, sB_c = sB_id - sB_jt * 24;
  const int w_jt = tid >> 4, w_c = tid & 15;
  uint4 rA, rB, rW, rK;
  auto gload = [&](int c) {
    const int tb = tok0 + (d == 0 ? c * SCH : L - SCH - c * SCH);
    rA = *(const uint4*)(p.SH + ((size_t)(tb + sA_jt) * 8 + hd) * 192 + sA_c * 8);
    if (tid < 128) rB = *(const uint4*)(p.SH + ((size_t)(tb + sB_jt) * 8 + hd) * 192 + sB_c * 8);
    rW = *(const uint4*)(p.DW + ((size_t)d * NTOK + tb + w_jt) * 512 + hd * 64 + w_c * 4);
    rK = *(const uint4*)(p.DK + (((size_t)d * NTOK + tb + w_jt) * 8 + hd) * 128 + w_c * 8);
  };
  auto put8 = [&](float* dst, uint4 v) {
    *(float4*)dst = make_float4(bflo(v.x), bfhi(v.x), bflo(v.y), bfhi(v.y));
    *(float4*)(dst + 4) = make_float4(bflo(v.z), bfhi(v.z), bflo(v.w), bfhi(v.w));
  };
  auto swrite = [&](int b) {
    float* bb = buf + b * (SCH * 384);
    {
      int arr = sA_c >> 3; int slot = arr == 0 ? 4 : (arr == 1 ? 5 : 0);
      put8(bb + sA_jt * 384 + slot * 64 + (sA_c & 7) * 8, rA);
    }
    if (tid < 128) {
      int arr = sB_c >> 3; int slot = arr == 0 ? 4 : (arr == 1 ? 5 : 0);
      put8(bb + sB_jt * 384 + slot * 64 + (sB_c & 7) * 8, rB);
    }
    *(uint4*)(bb + w_jt * 384 + 1 * 64 + w_c * 4) = rW;
    {
      int arr = w_c >> 3; int slot = arr == 0 ? 3 : 2;
      put8(bb + w_jt * 384 + slot * 64 + (w_c & 7) * 8, rK);
    }
  };
  gload(0);
  swrite(0);
  __syncthreads();
  float ykeep = 0.f;
  for (int c = 0; c < nchunk; ++c) {
    const bool more = (c + 1 < nchunk);
    if (more) gload(c + 1);
    const float* bb = buf + (c & 1) * (SCH * 384);
#pragma unroll 2
    for (int i = 0; i < SCH; ++i) {
      const int jt = (d == 0) ? i : (SCH - 1 - i);
      const float* st = bb + jt * 384 + seg * 8;
      float4 k0 = *(const float4*)(st), k1 = *(const float4*)(st + 4);
      float4 w0 = *(const float4*)(st + 64), w1 = *(const float4*)(st + 68);
      float4 b0 = *(const float4*)(st + 128), b1 = *(const float4*)(st + 132);
      float4 d0 = *(const float4*)(st + 192), d1 = *(const float4*)(st + 196);
      float4 r0 = *(const float4*)(st + 256), r1 = *(const float4*)(st + 260);
      const float vv = bb[jt * 384 + 320 + row];
      const float kk8[8] = {k0.x, k0.y, k0.z, k0.w, k1.x, k1.y, k1.z, k1.w};
      const float w8[8] = {w0.x, w0.y, w0.z, w0.w, w1.x, w1.y, w1.z, w1.w};
      const float b8[8] = {b0.x, b0.y, b0.z, b0.w, b1.x, b1.y, b1.z, b1.w};
      const float d8[8] = {d0.x, d0.y, d0.z, d0.w, d1.x, d1.y, d1.z, d1.w};
      const float r8[8] = {r0.x, r0.y, r0.z, r0.w, r1.x, r1.y, r1.z, r1.w};
      float dot = 0.f;
#pragma unroll
      for (int j = 0; j < 8; ++j) dot += S[j] * kk8[j];
      dot = red8(dot);
      const float sa = -dot;
      float yv = 0.f;
#pragma unroll
      for (int j = 0; j < 8; ++j) {
        S[j] = S[j] * w8[j] + (sa * b8[j] + vv * d8[j]);
        yv += S[j] * r8[j];
      }
      yv = red8(yv);
      if (seg == (i & 7)) ykeep = yv;
      if ((i & 7) == 7) {
        const int ii = (i & ~7) + seg;
        const int tt = (d == 0) ? (c * SCH + ii) : (L - 1 - (c * SCH + ii));
        p.Y[((size_t)d * NTOK + tok0 + tt) * 512 + hd * 64 + row] = ykeep;
      }
    }
    if (more) swrite((c + 1) & 1);
    __syncthreads();
  }
  if (sout) {
    *(float4*)(sout + row * 64 + seg * 8) = make_float4(S[0], S[1], S[2], S[3]);
    *(float4*)(sout + row * 64 + seg * 8 + 4) = make_float4(S[4], S[5], S[6], S[7]);
  }
}

#define KV_STRIDE 144
DI void attn_unit(const bf16_t* __restrict__ Q, const bf16_t* __restrict__ Kb, const bf16_t* __restrict__ Vt, int LK, bf16_t* __restrict__ O, char* smem) {
  const int tid = threadIdx.x, lane = tid & 63, wave = tid >> 6;
  const int n = lane & 31, hh = lane >> 5;
  char* Ks = smem;
  char* Vs = smem + 64 * KV_STRIDE;
  bf16x8 qf[4];
#pragma unroll
  for (int ks = 0; ks < 4; ++ks) qf[ks] = *(const bf16x8*)(Q + (size_t)(wave * 32 + n) * 64 + ks * 16 + hh * 8);
  f32x16 ot[2];
#pragma unroll
  for (int dt = 0; dt < 2; ++dt)
#pragma unroll
    for (int r = 0; r < 16; ++r) ot[dt][r] = 0.f;
  float mrun = -1e30f, lrun = 0.f;
  const int ntile = LK >> 6;
  const int lrow = tid >> 3, lc = tid & 7;
  uint4 rk0, rk1, rv0, rv1;
  rk0 = *(const uint4*)(Kb + (size_t)(lrow) * 64 + lc * 8);
  rk1 = *(const uint4*)(Kb + (size_t)(lrow + 32) * 64 + lc * 8);
  rv0 = *(const uint4*)(Vt + (size_t)(lrow) * LK + lc * 8);
  rv1 = *(const uint4*)(Vt + (size_t)(lrow + 32) * LK + lc * 8);
  for (int kt = 0; kt < ntile; ++kt) {
    *(uint4*)(Ks + (lrow) * KV_STRIDE + lc * 16) = rk0;
    *(uint4*)(Ks + (lrow + 32) * KV_STRIDE + lc * 16) = rk1;
    *(uint4*)(Vs + (lrow) * KV_STRIDE + lc * 16) = rv0;
    *(uint4*)(Vs + (lrow + 32) * KV_STRIDE + lc * 16) = rv1;
    __syncthreads();
    if (kt + 1 < ntile) {
      rk0 = *(const uint4*)(Kb + (size_t)((kt + 1) * 64 + lrow) * 64 + lc * 8);
      rk1 = *(const uint4*)(Kb + (size_t)((kt + 1) * 64 + lrow + 32) * 64 + lc * 8);
      rv0 = *(const uint4*)(Vt + (size_t)(lrow) * LK + (kt + 1) * 64 + lc * 8);
      rv1 = *(const uint4*)(Vt + (size_t)(lrow + 32) * LK + (kt + 1) * 64 + lc * 8);
    }
    f32x16 st[2];
#pragma unroll
    for (int kb = 0; kb < 2; ++kb) {
#pragma unroll
      for (int r = 0; r < 16; ++r) st[kb][r] = 0.f;
#pragma unroll
      for (int ks = 0; ks < 4; ++ks) {
        bf16x8 af = *(const bf16x8*)(Ks + (kb * 32 + n) * KV_STRIDE + (ks * 2 + hh) * 16);
        st[kb] = MFMA(af, qf[ks], st[kb]);
      }
    }
    float mx = st[0][0];
#pragma unroll
    for (int kb = 0; kb < 2; ++kb)
#pragma unroll
      for (int r = 0; r < 16; ++r) mx = fmaxf(mx, st[kb][r]);
    mx = fmaxf(mx, __shfl_xor(mx, 32));
    const float mnew = fmaxf(mrun, mx);
    const float alpha = __builtin_amdgcn_exp2f(mrun - mnew);
    mrun = mnew;
    float ps = 0.f;
#pragma unroll
    for (int kb = 0; kb < 2; ++kb)
#pragma unroll
      for (int r = 0; r < 16; ++r) { float e = __builtin_amdgcn_exp2f(st[kb][r] - mnew); st[kb][r] = e; ps += e; }
    lrun = lrun * alpha + ps;
#pragma unroll
    for (int dt = 0; dt < 2; ++dt)
#pragma unroll
      for (int r = 0; r < 16; ++r) ot[dt][r] *= alpha;
#pragma unroll
    for (int kb = 0; kb < 2; ++kb)
#pragma unroll
      for (int s = 0; s < 2; ++s) {
        uint4 pk = make_uint4(pack2(st[kb][8 * s + 0], st[kb][8 * s + 1]), pack2(st[kb][8 * s + 2], st[kb][8 * s + 3]),
                              pack2(st[kb][8 * s + 4], st[kb][8 * s + 5]), pack2(st[kb][8 * s + 6], st[kb][8 * s + 7]));
        bf16x8 pf = __builtin_bit_cast(bf16x8, pk);
#pragma unroll
        for (int dt = 0; dt < 2; ++dt) {
          const char* vp = Vs + (dt * 32 + n) * KV_STRIDE + (kb * 32 + 16 * s + 4 * hh) * 2;
          uint2 lo = *(const uint2*)(vp), hi = *(const uint2*)(vp + 16);
          bf16x8 vf = __builtin_bit_cast(bf16x8, make_uint4(lo.x, lo.y, hi.x, hi.y));
          ot[dt] = MFMA(vf, pf, ot[dt]);
        }
      }
    __syncthreads();
  }
  lrun += __shfl_xor(lrun, 32);
  const float inv = 1.f / lrun;
#pragma unroll
  for (int dt = 0; dt < 2; ++dt)
#pragma unroll
    for (int g = 0; g < 4; ++g) {
      int dd = dt * 32 + 8 * g + 4 * hh;
      *(uint2*)(O + (size_t)(wave * 32 + n) * 512 + dd) =
          make_uint2(pack2(ot[dt][4 * g] * inv, ot[dt][4 * g + 1] * inv), pack2(ot[dt][4 * g + 2] * inv, ot[dt][4 * g + 3] * inv));
    }
}

DI void phase4(const Params& p, int u, char* smem) {
  if (u < 128) {
    const int scan = u >> 1, rh = u & 1;
    const int b = scan >> 4, hd = (scan >> 1) & 7, d = scan & 1;
    scan_unit(p, 4096 + b * 1024, 1024, hd, d, rh, p.state + ((size_t)(b * 2 + d) * 8 + hd) * 4096, nullptr, smem);
  } else if (u < 256) {
#pragma unroll 1
    for (int j = 0; j < 4; ++j) {
      const int cu = (u - 128) * 4 + j;
      const int scan = cu >> 1, rh = cu & 1;
      const int s = scan >> 4, hd = (scan >> 1) & 7, d = scan & 1;
      scan_unit(p, s * 256, 256, hd, d, rh, nullptr, p.out + (size_t)2 * 4194304 + 2 * 524288 + ((size_t)(s * 2 + d) * 8 + hd) * 4096, smem);
    }
  } else {
    const int a = u - 256;
    {
      const int qb = a & 7, hd = (a >> 3) & 7, b = a >> 6;
      const int kvh = hd >> 2;
      attn_unit(p.q + (size_t)4096 * 512 + ((size_t)(b * 8 + hd) * 1024 + qb * 128) * 64, p.Kl + (size_t)(b * 2 + kvh) * 1536 * 64,
                p.Vtl + (size_t)(b * 2 + kvh) * 64 * 1536, 1536, p.attn_o + (size_t)(4096 + b * 1024 + qb * 128) * 512 + hd * 64, smem);
    }
    {
      const int qb = a & 1, hd = (a >> 1) & 7, s = a >> 4;
      const int kvh = hd >> 2;
      attn_unit(p.q + ((size_t)(s * 8 + hd) * 256 + qb * 128) * 64, p.Kc + (size_t)(s * 2 + kvh) * 256 * 64,
                p.Vtc + (size_t)(s * 2 + kvh) * 64 * 256, 256, p.attn_o + (size_t)(s * 256 + qb * 128) * 512 + hd * 64, smem);
    }
  }
}

DI void rwkv_final_token(const Params& p, int tok) {
  const int lane = threadIdx.x & 63;
  const int hd = lane >> 3, sub = lane & 7;
  const int ch = hd * 64 + sub * 8;
  const float* y0 = p.Y + (size_t)tok * 512 + ch;
  const float* y1 = p.Y + ((size_t)NTOK + tok) * 512 + ch;
  float4 a0 = *(const float4*)y0, a1 = *(const float4*)(y0 + 4), b0 = *(const float4*)y1, b1 = *(const float4*)(y1 + 4);
  float y[8] = {a0.x + b0.x, a0.y + b0.y, a0.z + b0.z, a0.w + b0.w, a1.x + b1.x, a1.y + b1.y, a1.z + b1.z, a1.w + b1.w};
  float s = 0.f;
#pragma unroll
  for (int j = 0; j < 8; ++j) s += y[j];
  const float mu = red8(s) * (1.f / 64.f);
  float vs = 0.f;
#pragma unroll
  for (int j = 0; j < 8; ++j) { y[j] -= mu; vs += y[j] * y[j]; }
  const float rstd = rsqrtf(red8(vs) * (1.f / 64.f) + 64e-5f);
  const float2 bsv = *(const float2*)(p.BS + ((size_t)tok * 8 + hd) * 2);
  const float bsum = bsv.x + bsv.y;
  uint4 vraw = *(const uint4*)(p.SH + ((size_t)tok * 8 + hd) * 192 + 64 + sub * 8);
  uint4 graw = *(const uint4*)(p.gbuf + (size_t)tok * 512 + ch);
  const float vv[8] = {bflo(vraw.x), bfhi(vraw.x), bflo(vraw.y), bfhi(vraw.y), bflo(vraw.z), bfhi(vraw.z), bflo(vraw.w), bfhi(vraw.w)};
  const float gg[8] = {bflo(graw.x), bfhi(graw.x), bflo(graw.y), bfhi(graw.y), bflo(graw.z), bfhi(graw.z), bflo(graw.w), bfhi(graw.w)};
  float4 lg0 = *(const float4*)(p.ln_g + ch), lg1 = *(const float4*)(p.ln_g + ch + 4);
  float4 lb0 = *(const float4*)(p.ln_b + ch), lb1 = *(const float4*)(p.ln_b + ch + 4);
  const float lg[8] = {lg0.x, lg0.y, lg0.z, lg0.w, lg1.x, lg1.y, lg1.z, lg1.w};
  const float lb[8] = {lb0.x, lb0.y, lb0.z, lb0.w, lb1.x, lb1.y, lb1.z, lb1.w};
  float o[8];
#pragma unroll
  for (int j = 0; j < 8; ++j) o[j] = (y[j] * rstd * lg[j] + lb[j] + bsum * vv[j]) * gg[j];
  *(uint4*)(p.rwkv_o + (size_t)tok * 512 + ch) = make_uint4(pack2(o[0], o[1]), pack2(o[2], o[3]), pack2(o[4], o[5]), pack2(o[6], o[7]));
}

DI void unpack8(uint4 v, float (&o)[8]) {
  o[0] = bflo(v.x); o[1] = bfhi(v.x); o[2] = bflo(v.y); o[3] = bfhi(v.y); o[4] = bflo(v.z); o[5] = bfhi(v.z); o[6] = bflo(v.w); o[7] = bfhi(v.w);
}
DI void ffn_act_unit(const Params& p, int u) {
  const int item = u * 256 + threadIdx.x;
  const int tile = item / 352, grp = item - tile * 352;
  const int tok0 = tile * 8;
  int seq_start, L;
  if (tok0 < 4096) { seq_start = tok0 & ~255; L = 256; } else { seq_start = 4096 + ((tok0 - 4096) & ~1023); L = 1024; }
  const int cu = grp * 8, cgc = 2816 + grp * 8;
  float wu[3][8], wg[3][8];
#pragma unroll
  for (int j = 0; j < 3; ++j) {
    float4 a = *(const float4*)(p.ffn_conv + j * 5632 + cu), b = *(const float4*)(p.ffn_conv + j * 5632 + cu + 4);
    wu[j][0] = a.x; wu[j][1] = a.y; wu[j][2] = a.z; wu[j][3] = a.w; wu[j][4] = b.x; wu[j][5] = b.y; wu[j][6] = b.z; wu[j][7] = b.w;
    float4 c = *(const float4*)(p.ffn_conv + j * 5632 + cgc), d = *(const float4*)(p.ffn_conv + j * 5632 + cgc + 4);
    wg[j][0] = c.x; wg[j][1] = c.y; wg[j][2] = c.z; wg[j][3] = c.w; wg[j][4] = d.x; wg[j][5] = d.y; wg[j][6] = d.z; wg[j][7] = d.w;
  }
  float pu[8], pg[8], cu8[8], cg8[8], nu[8], ng[8];
  if (tok0 > seq_start) {
    unpack8(*(const uint4*)(p.up + (size_t)(tok0 - 1) * 5632 + cu), pu);
    unpack8(*(const uint4*)(p.up + (size_t)(tok0 - 1) * 5632 + cgc), pg);
  } else {
#pragma unroll
    for (int j = 0; j < 8; ++j) { pu[j] = 0.f; pg[j] = 0.f; }
  }
  unpack8(*(const uint4*)(p.up + (size_t)tok0 * 5632 + cu), cu8);
  unpack8(*(const uint4*)(p.up + (size_t)tok0 * 5632 + cgc), cg8);
#pragma unroll 1
  for (int i = 0; i < 8; ++i) {
    const int tk = tok0 + i;
    if (tk + 1 < seq_start + L) {
      unpack8(*(const uint4*)(p.up + (size_t)(tk + 1) * 5632 + cu), nu);
      unpack8(*(const uint4*)(p.up + (size_t)(tk + 1) * 5632 + cgc), ng);
    } else {
#pragma unroll
      for (int j = 0; j < 8; ++j) { nu[j] = 0.f; ng[j] = 0.f; }
    }
    float o[8];
#pragma unroll
    for (int j = 0; j < 8; ++j) {
      float uu = pu[j] * wu[0][j] + cu8[j] * wu[1][j] + nu[j] * wu[2][j];
      float gg = pg[j] * wg[0][j] + cg8[j] * wg[1][j] + ng[j] * wg[2][j];
      o[j] = gg * sigmoidf_(gg) * uu;
      pu[j] = cu8[j]; pg[j] = cg8[j]; cu8[j] = nu[j]; cg8[j] = ng[j];
    }
    *(uint4*)(p.act + (size_t)tk * 2816 + cu) = make_uint4(pack2(o[0], o[1]), pack2(o[2], o[3]), pack2(o[4], o[5]), pack2(o[6], o[7]));
  }
}

#define NPHASE 13
template <int PH> DI void run_phase(const Params& p, char* smem) {
  const int nb = gridDim.x;
  if (PH == 0) for (int u = blockIdx.x; u < P0_UNITS; u += nb) phase0(p, u, smem);
  if (PH == 1) for (int u = blockIdx.x; u < 2048; u += nb) norm_rows<0>(p, u);
  if (PH == 2) for (int u = blockIdx.x; u < 64 * 36; u += nb) gemm_unit<0>(p, u, smem);
  if (PH == 3) for (int u = blockIdx.x; u < 512 + 2048 + 64; u += nb) {
    if (u < 512) rwkv_prep_unit(p, u, smem);
    else if (u < 512 + 2048) attn_prep_token(p, (u - 512) * 4 + (threadIdx.x >> 6));
    else cache_conv_unit(p, u - 2560, smem);
  }
  if (PH == 4) for (int u = blockIdx.x; u < 512; u += nb) phase4(p, u, smem);
  if (PH == 5) for (int u = blockIdx.x; u < 2048; u += nb) rwkv_final_token(p, u * 4 + (threadIdx.x >> 6));
  if (PH == 6) for (int u = blockIdx.x; u < 64 * 8; u += nb) gemm_unit<1>(p, u, smem);
  if (PH == 7) for (int u = blockIdx.x; u < 64 * 8; u += nb) gemm_unit<2>(p, u, smem);
  if (PH == 8) for (int u = blockIdx.x; u < 2048; u += nb) norm_rows<1>(p, u);
  if (PH == 9) for (int u = blockIdx.x; u < 64 * 44; u += nb) gemm_unit<3>(p, u, smem);
  if (PH == 10) for (int u = blockIdx.x; u < 1408; u += nb) ffn_act_unit(p, u);
  if (PH == 11) for (int u = blockIdx.x; u < 64 * 8; u += nb) gemm_unit<4>(p, u, smem);
  if (PH == 12) for (int u = blockIdx.x; u < 2048; u += nb) norm_rows<2>(p, u);
}

#if FUSED
__global__ void __launch_bounds__(256, 2) fwd_megakernel(Params p) {
  __shared__ __attribute__((aligned(16))) char smem[65536];
  cg::grid_group grid = cg::this_grid();
  run_phase<0>(p, smem); grid.sync();
  run_phase<1>(p, smem); grid.sync();
  run_phase<2>(p, smem); grid.sync();
  run_phase<3>(p, smem); grid.sync();
  run_phase<4>(p, smem); grid.sync();
  run_phase<5>(p, smem); grid.sync();
  run_phase<6>(p, smem); grid.sync();
  run_phase<7>(p, smem); grid.sync();
  run_phase<8>(p, smem); grid.sync();
  run_phase<9>(p, smem); grid.sync();
  run_phase<10>(p, smem); grid.sync();
  run_phase<11>(p, smem); grid.sync();
  run_phase<12>(p, smem);
}
#else
template <int PH> __global__ void __launch_bounds__(256, 2) phase_kernel(Params p) {
  __shared__ __attribute__((aligned(16))) char smem[65536];
  run_phase<PH>(p, smem);
}
#endif

extern "C" void kernel_launch(void* const* d_in, const int* in_sizes, int n_in, void* d_out, int out_size, void* d_ws,
                              size_t ws_size, hipStream_t stream) {
  Params p{};
  const float** fp = (const float**)&p;
  for (int i = 0; i < 32; ++i) fp[i] = (const float*)d_in[i];
  p.out = (float*)d_out;
  char* w = (char*)d_ws;
  size_t off = 0;
  auto take = [&](size_t bytes) { char* r = w + off; off += (bytes + 255) & ~(size_t)255; return r; };
  p.mod = (float*)take(5 * 6144 * 4);
  p.wt_in = (bf16_t*)take((size_t)4608 * 1024 * 2);
  p.wt_attn = (bf16_t*)take((size_t)1024 * 512 * 2);
  p.wt_rwkv = (bf16_t*)take((size_t)1024 * 512 * 2);
  p.wt_out = (bf16_t*)take((size_t)1024 * 1024 * 2);
  p.wt_up = (bf16_t*)take((size_t)5632 * 1024 * 2);
  p.wt_down = (bf16_t*)take((size_t)1024 * 2816 * 2);
  p.wt_w2 = (bf16_t*)take((size_t)2 * 512 * 64 * 2);
  p.wt_a2 = (bf16_t*)take((size_t)2 * 512 * 64 * 2);
  p.wt_g2 = (bf16_t*)take((size_t)512 * 128 * 2);
  p.h = (bf16_t*)take((size_t)NTOK * 1024 * 2);
  p.attn_o = p.h;
  p.rwkv_o = p.h + (size_t)NTOK * 512;
  p.projA = (bf16_t*)take((size_t)NTOK * 2560 * 2);
  p.gates = (bf16_t*)take((size_t)NTOK * 2048 * 2);
  p.Y = (float*)p.projA;
  p.act = p.projA;
  p.SH = (bf16_t*)take((size_t)NTOK * 8 * 192 * 2);
  p.DW = (float*)take((size_t)2 * NTOK * 512 * 4);
  p.DK = (bf16_t*)take((size_t)2 * NTOK * 8 * 128 * 2);
  p.up = p.SH;
  p.gbuf = (bf16_t*)take((size_t)NTOK * 512 * 2);
  p.BS = (float*)take((size_t)NTOK * 8 * 2 * 4);
  p.q = (bf16_t*)take((size_t)NTOK * 512 * 2);
  p.Kc = (bf16_t*)take((size_t)16 * 2 * 256 * 64 * 2);
  p.Kl = (bf16_t*)take((size_t)4 * 2 * 1536 * 64 * 2);
  p.Vtc = (bf16_t*)take((size_t)16 * 2 * 256 * 64 * 2);
  p.Vtl = (bf16_t*)take((size_t)4 * 2 * 1536 * 64 * 2);
  p.merged = (bf16_t*)take((size_t)NTOK * 1024 * 2);
  if (off > ws_size) { fprintf(stderr, "workspace too small: need %zu have %zu\n", off, ws_size); return; }
#if FUSED
  static int grid_blocks = 0;
  if (!grid_blocks) {
    int dev = 0, cus = 0, per_cu = 0;
    hipGetDevice(&dev);
    hipDeviceGetAttribute(&cus, hipDeviceAttributeMultiprocessorCount, dev);
    hipOccupancyMaxActiveBlocksPerMultiprocessor(&per_cu, fwd_megakernel, 256, 0);
    if (per_cu > 2) per_cu = 2;
    if (per_cu < 1) per_cu = 1;
    grid_blocks = cus * per_cu;
  }
  void* args[] = {&p};
  hipError_t e = hipLaunchCooperativeKernel((void*)fwd_megakernel, dim3(grid_blocks), dim3(256), args, 0, stream);
  if (e != hipSuccess) fprintf(stderr, "cooperative launch failed: %s (grid %d)\n", hipGetErrorString(e), grid_blocks);
#else
  const int G = 1024;
  phase_kernel<0><<<G, 256, 0, stream>>>(p);
  phase_kernel<1><<<G, 256, 0, stream>>>(p);
  phase_kernel<2><<<G, 256, 0, stream>>>(p);
  phase_kernel<3><<<G, 256, 0, stream>>>(p);
  phase_kernel<4><<<512, 256, 0, stream>>>(p);
  phase_kernel<5><<<G, 256, 0, stream>>>(p);
  phase_kernel<6><<<G, 256, 0, stream>>>(p);
  phase_kernel<7><<<G, 256, 0, stream>>>(p);
  phase_kernel<8><<<G, 256, 0, stream>>>(p);
  phase_kernel<9><<<G, 256, 0, stream>>>(p);
  phase_kernel<10><<<G, 256, 0, stream>>>(p);
  phase_kernel<11><<<G, 256, 0, stream>>>(p);
  phase_kernel<12><<<G, 256, 0, stream>>>(p);
#endif
}
```

```cpp
#include <hip/hip_runtime.h>
#include <hip/hip_cooperative_groups.h>
#include <cstdio>
namespace cg = cooperative_groups;

#ifndef FUSED
#define FUSED 1
#endif

typedef unsigned short bf16_t;
typedef __attribute__((ext_vector_type(8))) short bf16x8;
typedef __attribute__((ext_vector_type(16))) float f32x16;
typedef __attribute__((ext_vector_type(2))) float f32x2;
typedef __attribute__((ext_vector_type(2))) __bf16 bf16x2_t;

#define DI __device__ __forceinline__
#define MFMA(a, b, c) __builtin_amdgcn_mfma_f32_32x32x16_bf16((a), (b), (c), 0, 0, 0)

#define NTOK 8192
#define QSCALE 0.18033688011112042f

struct Params {
  const float *x_prompt, *x_sample, *cache_k, *cache_v, *state, *c, *c_ctx, *w_ada, *b_ada, *norm1_g, *w_in,
      *q_norm_g, *k_norm_g, *rwkv_conv, *w0, *w2, *a0, *a2, *g2, *k_k, *k_a, *r_k, *ln_g, *ln_b, *w_attn_br,
      *w_rwkv_br, *w_out, *norm2_g, *ffn_up, *ffn_conv, *ffn_down, *final_g;
  float* out;
  float* mod;
  bf16_t *wt_in, *wt_attn, *wt_rwkv, *wt_out, *wt_up, *wt_down, *wt_w2, *wt_a2, *wt_g2;
  bf16_t* h;
  bf16_t *attn_o, *rwkv_o;
  bf16_t* projA;
  bf16_t* gates;
  float* Y;
  bf16_t* act;
  bf16_t* SH;
  float* DW;
  bf16_t* DK;
  bf16_t* up;
  bf16_t* edge;
  bf16_t* gbuf;
  float* BS;
  bf16_t* q;
  bf16_t *Kc, *Kl, *Vtc, *Vtl;
  bf16_t* merged;
  unsigned* bar;
  int never;
  int pad_;
};

DI unsigned pack2(float a, float b) {
  f32x2 v = {a, b};
  bf16x2_t r = __builtin_convertvector(v, bf16x2_t);
  return __builtin_bit_cast(unsigned, r);
}
DI bf16_t f2bf(float a) { return (bf16_t)(pack2(a, 0.f) & 0xffffu); }
DI float bflo(unsigned u) { return __uint_as_float(u << 16); }
DI float bfhi(unsigned u) { return __uint_as_float(u & 0xffff0000u); }
DI float bf2f(bf16_t b) { return __uint_as_float(((unsigned)b) << 16); }

template <int CTRL> DI float dppf(float x) {
  return __int_as_float(__builtin_amdgcn_update_dpp(0, __float_as_int(x), CTRL, 0xF, 0xF, true));
}
DI float red8(float x) {
  x += dppf<0xB1>(x);
  x += dppf<0x4E>(x);
  x += dppf<0x141>(x);
  return x;
}
DI float wave_sum(float x) {
#pragma unroll
  for (int o = 32; o >= 1; o >>= 1) x += __shfl_xor(x, o);
  return x;
}
DI const float* xrow(const Params& p, int tok) {
  return tok < 4096 ? p.x_prompt + (size_t)tok * 1024 : p.x_sample + (size_t)(tok - 4096) * 1024;
}
DI int modrow(int tok) { return tok < 4096 ? 0 : 1 + ((tok - 4096) >> 10); }
DI float sigmoidf_(float x) { return __builtin_amdgcn_rcpf(1.f + __expf(-x)); }

typedef __attribute__((ext_vector_type(2))) unsigned u32x2_t;
typedef __attribute__((ext_vector_type(4))) float f32x4_t;
DI void nt_store2(void* p, unsigned a, unsigned b) { u32x2_t v = {a, b}; __builtin_nontemporal_store(v, (u32x2_t*)p); }
DI void nt_store4f(void* p, float a, float b, float c, float d) { f32x4_t v = {a, b, c, d}; __builtin_nontemporal_store(v, (f32x4_t*)p); }
DI size_t SHidx(int tok, int hd, int arr, int c4g) { return ((((size_t)(hd * 256 + (tok >> 5)) * 3 + arr) * 16 + c4g) * 32 + (tok & 31)) * 4; }
DI size_t DKidx(int d, int tok, int hd, int arr, int c4g) { return ((((size_t)((d * 8 + hd) * 256 + (tok >> 5)) * 2 + arr) * 16 + c4g) * 32 + (tok & 31)) * 4; }
DI size_t DWidx(int d, int tok, int hd, int c4g) { return (((size_t)((d * 8 + hd) * 256 + (tok >> 5)) * 16 + c4g) * 32 + (tok & 31)) * 4; }
DI size_t Gidx(int tok, int hd, int c4g) { return (((size_t)(hd * 256 + (tok >> 5)) * 16 + c4g) * 32 + (tok & 31)) * 4; }
DI size_t BSidx(int tok, int hd) { return ((size_t)hd * NTOK + tok) * 2; }

DI void transpose_tile(const float* __restrict__ W, bf16_t* __restrict__ Wt, int K, int N, int tile, char* smem, const bool ugperm = false) {
  const int tid = threadIdx.x;
  const int ntn = N >> 6;
  const int tk = tile / ntn, tn = tile - tk * ntn;
  const int k0 = tk * 64, n0 = tn * 64;
  float* t = (float*)smem;
  const int tx = tid & 15, ty = tid >> 4;
#pragma unroll
  for (int i = 0; i < 4; ++i) {
    int k = ty + 16 * i;
    float4 v = *(const float4*)(W + (size_t)(k0 + k) * N + n0 + tx * 4);
    t[k * 65 + tx * 4 + 0] = v.x; t[k * 65 + tx * 4 + 1] = v.y; t[k * 65 + tx * 4 + 2] = v.z; t[k * 65 + tx * 4 + 3] = v.w;
  }
  __syncthreads();
  const int n = tid >> 2, kc = tid & 3;
  unsigned o[8];
#pragma unroll
  for (int j = 0; j < 8; ++j) o[j] = pack2(t[(kc * 16 + 2 * j) * 65 + n], t[(kc * 16 + 2 * j + 1) * 65 + n]);
  int drow = n0 + n;
  if (ugperm) {
    const bool isg = n0 >= 2816;
    const int cc = (isg ? n0 - 2816 : n0) + n;
    drow = (cc >> 6) * 128 + ((cc >> 5) & 1) * 64 + (isg ? 32 : 0) + (cc & 31);
  }
  uint4* dst = (uint4*)(Wt + (size_t)drow * K + k0 + kc * 16);
  dst[0] = make_uint4(o[0], o[1], o[2], o[3]);
  dst[1] = make_uint4(o[4], o[5], o[6], o[7]);
  __syncthreads();
}

#define P0_MOD_UNITS 384
#define P0_UNITS (P0_MOD_UNITS + 1152 + 128 + 128 + 256 + 1408 + 704 + 16 + 16 + 16)
DI void phase0(const Params& p, int u, char* smem) {
  const int tid = threadIdx.x;
  if (u < P0_MOD_UNITS) {
    float* sc = (float*)smem;
    float* red = sc + 5 * 1024;
    for (int i = tid; i < 5 * 1024; i += 256) {
      int r = i >> 10, k = i & 1023;
      float cv = (r == 0) ? p.c_ctx[k] : p.c[(r - 1) * 1024 + k];
      sc[i] = cv / (1.f + __expf(-cv));
    }
    __syncthreads();
    const int cgp = tid & 3, kg = tid >> 2;
    const int n = u * 16 + cgp * 4;
    float4 acc[5];
#pragma unroll
    for (int r = 0; r < 5; ++r) acc[r] = make_float4(0.f, 0.f, 0.f, 0.f);
#pragma unroll
    for (int kk = 0; kk < 16; ++kk) {
      int k = kg * 16 + kk;
      float4 w = *(const float4*)(p.w_ada + (size_t)k * 6144 + n);
#pragma unroll
      for (int r = 0; r < 5; ++r) {
        float s = sc[r * 1024 + k];
        acc[r].x += s * w.x; acc[r].y += s * w.y; acc[r].z += s * w.z; acc[r].w += s * w.w;
      }
    }
#pragma unroll
    for (int r = 0; r < 5; ++r) {
      float* d = red + (kg * 5 + r) * 16 + cgp * 4;
      d[0] = acc[r].x; d[1] = acc[r].y; d[2] = acc[r].z; d[3] = acc[r].w;
    }
    __syncthreads();
    if (tid < 80) {
      int r = tid >> 4, ci = tid & 15;
      float s = p.b_ada[u * 16 + ci];
      for (int g = 0; g < 64; ++g) s += red[(g * 5 + r) * 16 + ci];
      p.mod[r * 6144 + u * 16 + ci] = s;
    }
    __syncthreads();
    return;
  }
  int t = u - P0_MOD_UNITS;
  if (t < 1152) { transpose_tile(p.w_in, p.wt_in, 1024, 4608, t, smem); return; }
  t -= 1152;
  if (t < 128) { transpose_tile(p.w_attn_br, p.wt_attn, 512, 1024, t, smem); return; }
  t -= 128;
  if (t < 128) { transpose_tile(p.w_rwkv_br, p.wt_rwkv, 512, 1024, t, smem); return; }
  t -= 128;
  if (t < 256) { transpose_tile(p.w_out, p.wt_out, 1024, 1024, t, smem); return; }
  t -= 256;
  if (t < 1408) { transpose_tile(p.ffn_up, p.wt_up, 1024, 5632, t, smem, true); return; }
  t -= 1408;
  if (t < 704) { transpose_tile(p.ffn_down, p.wt_down, 2816, 1024, t, smem); return; }
  t -= 704;
  if (t < 16) { int d = t >> 3; transpose_tile(p.w2 + d * 64 * 512, p.wt_w2 + d * 512 * 64, 64, 512, t & 7, smem); return; }
  t -= 16;
  if (t < 16) { int d = t >> 3; transpose_tile(p.a2 + d * 64 * 512, p.wt_a2 + d * 512 * 64, 64, 512, t & 7, smem); return; }
  t -= 16;
  transpose_tile(p.g2, p.wt_g2, 128, 512, t, smem);
}

template <int MODE> DI void norm_rows(const Params& p, int u) {
  const int tid = threadIdx.x, wave = tid >> 6, lane = tid & 63;
  const int tok0 = u * 16 + wave * 4;
  float4 v[4][4];
#pragma unroll
  for (int rr = 0; rr < 4; ++rr) {
    const float* xr = (MODE == 0) ? xrow(p, tok0 + rr) : p.out + (size_t)(tok0 + rr) * 1024;
#pragma unroll
    for (int i = 0; i < 4; ++i) v[rr][i] = *(const float4*)(xr + lane * 4 + 256 * i);
  }
  const float* g = (MODE == 0) ? p.norm1_g : (MODE == 1) ? p.norm2_g : p.final_g;
  float4 gg[4];
#pragma unroll
  for (int i = 0; i < 4; ++i) gg[i] = *(const float4*)(g + lane * 4 + 256 * i);
  const float* mr = p.mod + modrow(tok0) * 6144 + (MODE == 1 ? 3 * 1024 : 0);
  float4 sh[4], scl[4];
  if (MODE < 2) {
#pragma unroll
    for (int i = 0; i < 4; ++i) { sh[i] = *(const float4*)(mr + lane * 4 + 256 * i); scl[i] = *(const float4*)(mr + 1024 + lane * 4 + 256 * i); }
  }
#pragma unroll
  for (int rr = 0; rr < 4; ++rr) {
    const int tok = tok0 + rr;
    float ss = 0.f;
#pragma unroll
    for (int i = 0; i < 4; ++i) ss += v[rr][i].x * v[rr][i].x + v[rr][i].y * v[rr][i].y + v[rr][i].z * v[rr][i].z + v[rr][i].w * v[rr][i].w;
    ss = wave_sum(ss);
    const float rstd = rsqrtf(ss * (1.f / 1024.f) + 1e-6f);
#pragma unroll
    for (int i = 0; i < 4; ++i) {
      int c = lane * 4 + 256 * i;
      float y0 = v[rr][i].x * rstd * gg[i].x, y1 = v[rr][i].y * rstd * gg[i].y, y2 = v[rr][i].z * rstd * gg[i].z, y3 = v[rr][i].w * rstd * gg[i].w;
      if (MODE < 2) {
        y0 = y0 * (1.f + scl[i].x) + sh[i].x; y1 = y1 * (1.f + scl[i].y) + sh[i].y; y2 = y2 * (1.f + scl[i].z) + sh[i].z; y3 = y3 * (1.f + scl[i].w) + sh[i].w;
        *(uint2*)(p.h + (size_t)tok * 1024 + c) = make_uint2(pack2(y0, y1), pack2(y2, y3));
      } else {
        *(float4*)(p.out + (size_t)tok * 1024 + c) = make_float4(y0, y1, y2, y3);
      }
    }
  }
}

DI void gemm_mainloop(f32x16 (&acc)[2][2], const bf16_t* __restrict__ A, int lda, const bf16_t* __restrict__ Bt, int ldb, int K, char* smem) {
  const int tid = threadIdx.x, lane = tid & 63, wave = tid >> 6;
  const int wm = wave >> 1, wn = wave & 1;
  const int lr = tid >> 3, lc = tid & 7;
  const bf16_t* ap = A + (size_t)lr * lda + lc * 8;
  const bf16_t* bp = Bt + (size_t)lr * ldb + lc * 8;
  const int woff = lr * 128 + ((lc ^ (lr & 7)) << 4);
  const size_t sa = (size_t)32 * lda, sb = (size_t)32 * ldb;
  uint4 a0, a1, a2, a3, b0, b1, b2, b3;
  uint4 c0, c1, c2, c3, d0, d1, d2, d3;
#define GL0(k0) do { a0 = *(const uint4*)(ap + (k0)); a1 = *(const uint4*)(ap + sa + (k0)); a2 = *(const uint4*)(ap + 2 * sa + (k0)); a3 = *(const uint4*)(ap + 3 * sa + (k0)); \
                     b0 = *(const uint4*)(bp + (k0)); b1 = *(const uint4*)(bp + sb + (k0)); b2 = *(const uint4*)(bp + 2 * sb + (k0)); b3 = *(const uint4*)(bp + 3 * sb + (k0)); } while (0)
#define GL1(k0) do { c0 = *(const uint4*)(ap + (k0)); c1 = *(const uint4*)(ap + sa + (k0)); c2 = *(const uint4*)(ap + 2 * sa + (k0)); c3 = *(const uint4*)(ap + 3 * sa + (k0)); \
                     d0 = *(const uint4*)(bp + (k0)); d1 = *(const uint4*)(bp + sb + (k0)); d2 = *(const uint4*)(bp + 2 * sb + (k0)); d3 = *(const uint4*)(bp + 3 * sb + (k0)); } while (0)
#define SW0(buf) do { char* w_ = smem + (buf) * 32768 + woff; *(uint4*)(w_) = a0; *(uint4*)(w_ + 4096) = a1; *(uint4*)(w_ + 8192) = a2; *(uint4*)(w_ + 12288) = a3; \
                      *(uint4*)(w_ + 16384) = b0; *(uint4*)(w_ + 20480) = b1; *(uint4*)(w_ + 24576) = b2; *(uint4*)(w_ + 28672) = b3; } while (0)
#define SW1(buf) do { char* w_ = smem + (buf) * 32768 + woff; *(uint4*)(w_) = c0; *(uint4*)(w_ + 4096) = c1; *(uint4*)(w_ + 8192) = c2; *(uint4*)(w_ + 12288) = c3; \
                      *(uint4*)(w_ + 16384) = d0; *(uint4*)(w_ + 20480) = d1; *(uint4*)(w_ + 24576) = d2; *(uint4*)(w_ + 28672) = d3; } while (0)
  const int l31 = lane & 31, hh = lane >> 5, l7 = lane & 7;
  const int arow = (wm * 64 + l31) * 128, brow = 16384 + (wn * 64 + l31) * 128;
#define COMPUTE(buf) do { const char* as_ = smem + (buf) * 32768; \
    _Pragma("unroll") for (int ks = 0; ks < 4; ++ks) { \
      const int ch = ((ks * 2 + hh) ^ l7) << 4; \
      bf16x8 af0 = *(const bf16x8*)(as_ + arow + ch), af1 = *(const bf16x8*)(as_ + arow + 4096 + ch); \
      bf16x8 bf0 = *(const bf16x8*)(as_ + brow + ch), bf1 = *(const bf16x8*)(as_ + brow + 4096 + ch); \
      acc[0][0] = MFMA(af0, bf0, acc[0][0]); acc[0][1] = MFMA(af0, bf1, acc[0][1]); \
      acc[1][0] = MFMA(af1, bf0, acc[1][0]); acc[1][1] = MFMA(af1, bf1, acc[1][1]); } } while (0)
  const int nk = K >> 6;
  const int klast = (nk - 1) * 64;
  GL0(0);
  SW0(0);
  GL0(64);
  GL1(min(128, klast));
  __syncthreads();
  for (int kt = 0; kt < nk; kt += 2) {
    COMPUTE(0);
    SW0(1);
    GL0(min((kt + 3) * 64, klast));
    __syncthreads();
    COMPUTE(1);
    SW1(0);
    GL1(min((kt + 4) * 64, klast));
    __syncthreads();
  }
#undef GL0
#undef GL1
#undef SW0
#undef SW1
#undef COMPUTE
}

DI void zero_acc(f32x16 (&acc)[2][2]) {
#pragma unroll
  for (int i = 0; i < 2; ++i)
#pragma unroll
    for (int j = 0; j < 2; ++j)
#pragma unroll
      for (int r = 0; r < 16; ++r) acc[i][j][r] = 0.f;
}

template <int EPI> DI void gemm_unit(const Params& p, int u, char* smem) {
  const int mt = u & 63, nt = u >> 6;
  const int m0 = mt * 128, n0 = nt * 128;
  const int tid = threadIdx.x, lane = tid & 63, wave = tid >> 6;
  const int wm = wave >> 1, wn = wave & 1, l31 = lane & 31, hh = lane >> 5;
  f32x16 acc[2][2];
  zero_acc(acc);
  if (EPI == 0) gemm_mainloop(acc, p.h + (size_t)m0 * 1024, 1024, p.wt_in + (size_t)n0 * 1024, 1024, 1024, smem);
  if (EPI == 2) gemm_mainloop(acc, p.merged + (size_t)m0 * 1024, 1024, p.wt_out + (size_t)n0 * 1024, 1024, 1024, smem);
  if (EPI == 3) gemm_mainloop(acc, p.h + (size_t)m0 * 1024, 1024, p.wt_up + (size_t)n0 * 1024, 1024, 1024, smem);
  if (EPI == 4) gemm_mainloop(acc, p.act + (size_t)m0 * 2816, 2816, p.wt_down + (size_t)n0 * 2816, 2816, 2816, smem);
  if (EPI == 1) gemm_mainloop(acc, p.attn_o + (size_t)m0 * 512, 512, p.wt_attn + (size_t)n0 * 512, 512, 512, smem);
  if (EPI == 5) gemm_mainloop(acc, p.rwkv_o + (size_t)m0 * 512, 512, p.wt_rwkv + (size_t)n0 * 512, 512, 512, smem);
  float* et = (float*)smem;
#pragma unroll
  for (int i = 0; i < 2; ++i)
#pragma unroll
    for (int j = 0; j < 2; ++j)
#pragma unroll
      for (int r = 0; r < 16; ++r)
        et[(wm * 64 + i * 32 + (r & 3) + 8 * (r >> 2) + 4 * hh) * 132 + wn * 64 + j * 32 + l31] = acc[i][j][r];
  __syncthreads();
#pragma unroll 4
  for (int it = 0; it < 16; ++it) {
    const int id = tid + 256 * it;
    const int row = id >> 5, c4 = (id & 31) * 4;
    const float4 v = *(const float4*)(et + row * 132 + c4);
    const int m = m0 + row, n = n0 + c4;
    if (EPI == 0) {
      const uint2 o = make_uint2(pack2(v.x, v.y), pack2(v.z, v.w));
      if (n0 < 2560) *(uint2*)(p.projA + (size_t)m * 2560 + n) = o;
      else *(uint2*)(p.gates + (size_t)m * 2048 + (n - 2560)) = o;
    } else if (EPI == 1) {
      const uint2 g = *(const uint2*)(p.gates + (size_t)m * 2048 + n);
      *(uint2*)(p.merged + (size_t)m * 1024 + n) = make_uint2(pack2(v.x * sigmoidf_(bflo(g.x)), v.y * sigmoidf_(bfhi(g.x))),
                                                             pack2(v.z * sigmoidf_(bflo(g.y)), v.w * sigmoidf_(bfhi(g.y))));
    } else if (EPI == 5) {
      const uint2 g = *(const uint2*)(p.gates + (size_t)m * 2048 + 1024 + n);
      uint2* mp = (uint2*)(p.merged + (size_t)m * 1024 + n);
      const uint2 o = *mp;
      *mp = make_uint2(pack2(bflo(o.x) + v.x * sigmoidf_(bflo(g.x)), bfhi(o.x) + v.y * sigmoidf_(bfhi(g.x))),
                       pack2(bflo(o.y) + v.z * sigmoidf_(bflo(g.y)), bfhi(o.y) + v.w * sigmoidf_(bfhi(g.y))));
    } else if (EPI == 2) {
      const float4 g1 = *(const float4*)(p.mod + modrow(m) * 6144 + 2 * 1024 + n);
      const float4 x = *(const float4*)(xrow(p, m) + n);
      *(float4*)(p.out + (size_t)m * 1024 + n) = make_float4(x.x + g1.x * v.x, x.y + g1.y * v.y, x.z + g1.z * v.z, x.w + g1.w * v.w);
    } else if (EPI == 3) {
      *(uint2*)(p.up + (size_t)m * 5632 + n) = make_uint2(pack2(v.x, v.y), pack2(v.z, v.w));
    } else {
      const float4 g2 = *(const float4*)(p.mod + modrow(m) * 6144 + 5 * 1024 + n);
      float4* o = (float4*)(p.out + (size_t)m * 1024 + n);
      const float4 x = *o;
      *o = make_float4(x.x + g2.x * v.x, x.y + g2.y * v.y, x.z + g2.z * v.z, x.w + g2.w * v.w);
    }
  }
  __syncthreads();
}

#define WPITCH 80
#define WSTAGE (384 * WPITCH)
DI void gemm_mainloop_wide(f32x16 (&acc)[4][2], const bf16_t* __restrict__ A, const bf16_t* __restrict__ Bt, char* smem) {
  const int tid = threadIdx.x, lane = tid & 63, wave = tid >> 6;
  const int wm = wave >> 1, wn = wave & 1;
  const int lr = tid >> 2, lc = tid & 3;
  const bf16_t* ap = A + (size_t)lr * 1024 + lc * 8;
  const bf16_t* bp = Bt + (size_t)lr * 1024 + lc * 8;
  const int woff = lr * WPITCH + lc * 16;
  const size_t st64 = (size_t)64 * 1024;
  uint4 a0, a1, a2, a3, b0, b1;
  uint4 c0, c1, c2, c3, d0, d1;
#define WGL0(k0) do { a0 = *(const uint4*)(ap + (k0)); a1 = *(const uint4*)(ap + st64 + (k0)); a2 = *(const uint4*)(ap + 2 * st64 + (k0)); a3 = *(const uint4*)(ap + 3 * st64 + (k0)); \
                      b0 = *(const uint4*)(bp + (k0)); b1 = *(const uint4*)(bp + st64 + (k0)); } while (0)
#define WGL1(k0) do { c0 = *(const uint4*)(ap + (k0)); c1 = *(const uint4*)(ap + st64 + (k0)); c2 = *(const uint4*)(ap + 2 * st64 + (k0)); c3 = *(const uint4*)(ap + 3 * st64 + (k0)); \
                      d0 = *(const uint4*)(bp + (k0)); d1 = *(const uint4*)(bp + st64 + (k0)); } while (0)
#define WSW0(buf) do { char* w_ = smem + (buf) * WSTAGE + woff; *(uint4*)(w_) = a0; *(uint4*)(w_ + 64 * WPITCH) = a1; *(uint4*)(w_ + 128 * WPITCH) = a2; *(uint4*)(w_ + 192 * WPITCH) = a3; \
                       *(uint4*)(w_ + 256 * WPITCH) = b0; *(uint4*)(w_ + 320 * WPITCH) = b1; } while (0)
#define WSW1(buf) do { char* w_ = smem + (buf) * WSTAGE + woff; *(uint4*)(w_) = c0; *(uint4*)(w_ + 64 * WPITCH) = c1; *(uint4*)(w_ + 128 * WPITCH) = c2; *(uint4*)(w_ + 192 * WPITCH) = c3; \
                       *(uint4*)(w_ + 256 * WPITCH) = d0; *(uint4*)(w_ + 320 * WPITCH) = d1; } while (0)
  const int l31 = lane & 31, hh = lane >> 5;
  const int arow = (wm * 128 + l31) * WPITCH, brow = (256 + wn * 64 + l31) * WPITCH;
#define WCOMPUTE(buf) do { const char* as_ = smem + (buf) * WSTAGE; \
    _Pragma("unroll") for (int ks = 0; ks < 2; ++ks) { \
      const int ch = (ks * 2 + hh) * 16; \
      bf16x8 bf0 = *(const bf16x8*)(as_ + brow + ch), bf1 = *(const bf16x8*)(as_ + brow + 32 * WPITCH + ch); \
      _Pragma("unroll") for (int i = 0; i < 4; ++i) { \
        bf16x8 af = *(const bf16x8*)(as_ + arow + i * 32 * WPITCH + ch); \
        acc[i][0] = MFMA(af, bf0, acc[i][0]); acc[i][1] = MFMA(af, bf1, acc[i][1]); } } } while (0)
  const int nk = 32;
  const int klast = (nk - 1) * 32;
  WGL0(0);
  WSW0(0);
  WGL0(32);
  WGL1(64);
  __syncthreads();
  for (int kt = 0; kt < nk; kt += 2) {
    WCOMPUTE(0);
    WSW0(1);
    WGL0(min((kt + 3) * 32, klast));
    __syncthreads();
    WCOMPUTE(1);
    WSW1(0);
    WGL1(min((kt + 4) * 32, klast));
    __syncthreads();
  }
#undef WGL0
#undef WGL1
#undef WSW0
#undef WSW1
#undef WCOMPUTE
}

template <int EPI> DI void gemm_unit_wide(const Params& p, int mt, int nt, char* smem) {
  const int m0 = mt * 256, n0 = nt * 128;
  const int tid = threadIdx.x, lane = tid & 63, wave = tid >> 6;
  const int wm = wave >> 1, wn = wave & 1, l31 = lane & 31, hh = lane >> 5;
  f32x16 acc[4][2];
#pragma unroll
  for (int i = 0; i < 4; ++i)
#pragma unroll
    for (int j = 0; j < 2; ++j)
#pragma unroll
      for (int r = 0; r < 16; ++r) acc[i][j][r] = 0.f;
  gemm_mainloop_wide(acc, p.h + (size_t)m0 * 1024, (EPI == 0 ? p.wt_in : p.wt_up) + (size_t)n0 * 1024, smem);
#pragma unroll
  for (int i = 0; i < 4; ++i)
#pragma unroll
    for (int j = 0; j < 2; ++j)
#pragma unroll
      for (int r = 0; r < 16; ++r) {
        if ((r & 7) == 0) asm volatile("" ::: "memory");
        const int m = m0 + wm * 128 + i * 32 + (r & 3) + 8 * (r >> 2) + 4 * hh;
        const int n = n0 + wn * 64 + j * 32 + l31;
        const float a = acc[i][j][r];
        (void)m; (void)n; (void)a;
      }
  if (EPI == 0) {
    char* wl = smem + wave * (128 * 144);
#pragma unroll
    for (int i = 0; i < 4; ++i)
#pragma unroll
      for (int j = 0; j < 2; ++j)
#pragma unroll
        for (int r = 0; r < 16; ++r) {
          const int row = i * 32 + (r & 3) + 8 * (r >> 2) + 4 * hh;
          *(bf16_t*)(wl + row * 144 + (j * 32 + l31) * 2) = f2bf(acc[i][j][r]);
        }
    __syncthreads();
    const int rr = lane >> 3, cc = lane & 7;
    bf16_t* dst = (n0 < 2560) ? p.projA + (size_t)(m0 + wm * 128) * 2560 + n0 + wn * 64 + cc * 8
                              : p.gates + (size_t)(m0 + wm * 128) * 2048 + (n0 - 2560) + wn * 64 + cc * 8;
    const size_t ldd = (n0 < 2560) ? 2560 : 2048;
#pragma unroll
    for (int it = 0; it < 16; ++it) {
      const int row = it * 8 + rr;
      *(uint4*)(dst + (size_t)row * ldd) = *(const uint4*)(wl + row * 144 + cc * 16);
    }
    __syncthreads();
  }
  if (EPI == 3) {
    char* wl = smem + wave * 16384;
#pragma unroll
    for (int i = 0; i < 4; ++i)
#pragma unroll
      for (int r = 0; r < 16; ++r) {
        const int row = i * 32 + (r & 3) + 8 * (r >> 2) + 4 * hh;
        *(bf16_t*)(wl + row * 64 + l31 * 2) = f2bf(acc[i][0][r]);
        *(bf16_t*)(wl + 8192 + row * 64 + l31 * 2) = f2bf(acc[i][1][r]);
      }
    __syncthreads();
    const int cp = lane & 15, rq = lane >> 4;
    const int chg = nt * 64 + wn * 32 + 2 * cp;
    float wu[3][2], wg[3][2];
#pragma unroll
    for (int j = 0; j < 3; ++j) {
      const float2 a_ = *(const float2*)(p.ffn_conv + j * 5632 + chg), b_ = *(const float2*)(p.ffn_conv + j * 5632 + 2816 + chg);
      wu[j][0] = a_.x; wu[j][1] = a_.y; wg[j][0] = b_.x; wg[j][1] = b_.y;
    }
    const int blk = mt * 2 + wm;
    const int rb = rq * 32;
    const char* ul = wl + cp * 4;
    const char* gl = wl + 8192 + cp * 4;
    unsigned pu = rb ? *(const unsigned*)(ul + (rb - 1) * 64) : 0u, pg = rb ? *(const unsigned*)(gl + (rb - 1) * 64) : 0u;
    unsigned cu = *(const unsigned*)(ul + rb * 64), cg = *(const unsigned*)(gl + rb * 64);
#pragma unroll 8
    for (int q = 0; q < 32; ++q) {
      const int L = rb + q;
      unsigned nu = 0u, ng = 0u;
      if (L < 127) { nu = *(const unsigned*)(ul + (L + 1) * 64); ng = *(const unsigned*)(gl + (L + 1) * 64); }
      if (L == 0 || L == 1 || L == 126 || L == 127) {
        bf16_t* e = p.edge + ((size_t)blk * 4 + (L < 2 ? L : L - 124)) * 5632;
        *(unsigned*)(e + chg) = cu; *(unsigned*)(e + 2816 + chg) = cg;
      }
      if (L != 0 && L != 127) {
        const float u0 = bflo(pu) * wu[0][0] + bflo(cu) * wu[1][0] + bflo(nu) * wu[2][0];
        const float u1 = bfhi(pu) * wu[0][1] + bfhi(cu) * wu[1][1] + bfhi(nu) * wu[2][1];
        const float g0 = bflo(pg) * wg[0][0] + bflo(cg) * wg[1][0] + bflo(ng) * wg[2][0];
        const float g1 = bfhi(pg) * wg[0][1] + bfhi(cg) * wg[1][1] + bfhi(ng) * wg[2][1];
        *(unsigned*)(p.act + (size_t)(blk * 128 + L) * 2816 + chg) = pack2(g0 * sigmoidf_(g0) * u0, g1 * sigmoidf_(g1) * u1);
      }
      pu = cu; pg = cg; cu = nu; cg = ng;
    }
    __syncthreads();
  }
}

DI void load4bf(const bf16_t* p, float (&o)[4]) {
  uint2 v = *(const uint2*)p;
  o[0] = bflo(v.x); o[1] = bfhi(v.x); o[2] = bflo(v.y); o[3] = bfhi(v.y);
}
struct APIn { uint2 qlo, qhi, klo, khi; };
DI APIn attn_prep_load(const Params& p, int tok, int lane) {
  const bf16_t* pr = p.projA + (size_t)tok * 2560;
  const int sub = lane & 7, hd = lane >> 3, kvh = (lane >> 3) & 1;
  APIn r;
  r.qlo = *(const uint2*)(pr + hd * 64 + sub * 4);
  r.qhi = *(const uint2*)(pr + hd * 64 + 32 + sub * 4);
  r.klo = *(const uint2*)(pr + 512 + kvh * 64 + sub * 4);
  r.khi = *(const uint2*)(pr + 512 + kvh * 64 + 32 + sub * 4);
  return r;
}
DI void unpk4(uint2 v, float (&o)[4]) { o[0] = bflo(v.x); o[1] = bfhi(v.x); o[2] = bflo(v.y); o[3] = bfhi(v.y); }
DI void attn_prep_token(const Params& p, int tok, int lane, const APIn& in) {
  const int sub = lane & 7;
  const bool latent = tok >= 4096;
  int s, t, L;
  if (!latent) { s = tok >> 8; t = tok & 255; L = 256; }
  else { s = (tok - 4096) >> 10; t = (tok - 4096) & 1023; L = 1024; }
  float cs[4], sn[4];
  if (latent) {
    const int row = t >> 6, col = t & 63;
#pragma unroll
    for (int i = 0; i < 4; ++i) {
      int pi = sub * 4 + i;
      float inv = __builtin_amdgcn_exp2f(-(float)(pi & 15) * 0.83048202372184059f);
      float ang = (pi < 16 ? (float)row : (float)col) * inv;
      sn[i] = __sinf(ang); cs[i] = __cosf(ang);
    }
  }
  {
    const int hd = lane >> 3;
    float lo[4], hi[4];
    unpk4(in.qlo, lo);
    unpk4(in.qhi, hi);
    float ss = 0.f;
#pragma unroll
    for (int i = 0; i < 4; ++i) ss += lo[i] * lo[i] + hi[i] * hi[i];
    ss = red8(ss);
    const float rinv = rsqrtf(ss * (1.f / 64.f) + 1e-6f);
    float4 gl = *(const float4*)(p.q_norm_g + sub * 4), gh = *(const float4*)(p.q_norm_g + 32 + sub * 4);
    const float glv[4] = {gl.x, gl.y, gl.z, gl.w}, ghv[4] = {gh.x, gh.y, gh.z, gh.w};
#pragma unroll
    for (int i = 0; i < 4; ++i) {
      float a = lo[i] * rinv * glv[i], b = hi[i] * rinv * ghv[i];
      if (latent) { float na = a * cs[i] - b * sn[i]; float nb = b * cs[i] + a * sn[i]; a = na; b = nb; }
      lo[i] = a * QSCALE; hi[i] = b * QSCALE;
    }
    size_t qo = latent ? (size_t)4096 * 512 + ((size_t)(s * 8 + hd) * 1024 + t) * 64 : ((size_t)(s * 8 + hd) * 256 + t) * 64;
    *(uint2*)(p.q + qo + sub * 4) = make_uint2(pack2(lo[0], lo[1]), pack2(lo[2], lo[3]));
    *(uint2*)(p.q + qo + 32 + sub * 4) = make_uint2(pack2(hi[0], hi[1]), pack2(hi[2], hi[3]));
  }
  {
    const int kvh = (lane >> 3) & 1;
    float lo[4], hi[4];
    unpk4(in.klo, lo);
    unpk4(in.khi, hi);
    float ss = 0.f;
#pragma unroll
    for (int i = 0; i < 4; ++i) ss += lo[i] * lo[i] + hi[i] * hi[i];
    ss = red8(ss);
    const float rinv = rsqrtf(ss * (1.f / 64.f) + 1e-6f);
    float4 gl = *(const float4*)(p.k_norm_g + sub * 4), gh = *(const float4*)(p.k_norm_g + 32 + sub * 4);
    const float glv[4] = {gl.x, gl.y, gl.z, gl.w}, ghv[4] = {gh.x, gh.y, gh.z, gh.w};
#pragma unroll
    for (int i = 0; i < 4; ++i) { lo[i] = lo[i] * rinv * glv[i]; hi[i] = hi[i] * rinv * ghv[i]; }
    if (lane < 16) {
      if (!latent) {
        float* ok = p.out + (size_t)2 * 4194304 + ((size_t)(s * 2 + kvh) * 256 + t) * 64;
        *(float4*)(ok + sub * 4) = make_float4(lo[0], lo[1], lo[2], lo[3]);
        *(float4*)(ok + 32 + sub * 4) = make_float4(hi[0], hi[1], hi[2], hi[3]);
        bf16_t* kb = p.Kc + ((size_t)(s * 2 + kvh) * 256 + t) * 64;
        *(uint2*)(kb + sub * 4) = make_uint2(pack2(lo[0], lo[1]), pack2(lo[2], lo[3]));
        *(uint2*)(kb + 32 + sub * 4) = make_uint2(pack2(hi[0], hi[1]), pack2(hi[2], hi[3]));
      } else {
#pragma unroll
        for (int i = 0; i < 4; ++i) {
          float a = lo[i], b = hi[i];
          lo[i] = a * cs[i] - b * sn[i]; hi[i] = b * cs[i] + a * sn[i];
        }
        bf16_t* kb = p.Kl + ((size_t)(s * 2 + kvh) * 1536 + t) * 64;
        *(uint2*)(kb + sub * 4) = make_uint2(pack2(lo[0], lo[1]), pack2(lo[2], lo[3]));
        *(uint2*)(kb + 32 + sub * 4) = make_uint2(pack2(hi[0], hi[1]), pack2(hi[2], hi[3]));
      }
    }
  }
  (void)L;
}

DI void attn_prep_unit(const Params& p, int u) {
  int lane = threadIdx.x & 63;
  asm volatile("" : "+v"(lane));
  const int tok0 = u * 16 + (threadIdx.x >> 6) * 4;
  APIn in[4];
#pragma unroll
  for (int i = 0; i < 4; ++i) in[i] = attn_prep_load(p, tok0 + i, lane);
#pragma unroll
  for (int i = 0; i < 4; ++i) attn_prep_token(p, tok0 + i, lane, in[i]);
}

DI void v_prep_unit(const Params& p, int u) {
  int tid = threadIdx.x;
  asm volatile("" : "+v"(tid));
  const int lane = tid & 63, wave = tid >> 6;
  const int tok0 = u * 32 + wave * 8;
  const bool latent = tok0 >= 4096;
  int s, t0, LK;
  if (!latent) { s = tok0 >> 8; t0 = tok0 & 255; LK = 256; }
  else { s = (tok0 - 4096) >> 10; t0 = (tok0 - 4096) & 1023; LK = 1536; }
#pragma unroll
  for (int kvh = 0; kvh < 2; ++kvh) {
    unsigned short raw[8];
#pragma unroll
    for (int j = 0; j < 8; ++j) raw[j] = p.projA[(size_t)(tok0 + j) * 2560 + 640 + kvh * 64 + lane];
    if (!latent) {
      float* ov = p.out + (size_t)2 * 4194304 + 524288 + ((size_t)(s * 2 + kvh) * 256 + t0) * 64 + lane;
#pragma unroll
      for (int j = 0; j < 8; ++j) ov[j * 64] = bf2f(raw[j]);
    }
    bf16_t* vt = (latent ? p.Vtl : p.Vtc) + ((size_t)(s * 2 + kvh) * 64 + lane) * LK + t0;
    *(uint4*)vt = make_uint4((unsigned)raw[0] | ((unsigned)raw[1] << 16), (unsigned)raw[2] | ((unsigned)raw[3] << 16),
                             (unsigned)raw[4] | ((unsigned)raw[5] << 16), (unsigned)raw[6] | ((unsigned)raw[7] << 16));
  }
}

DI void cache_conv_unit(const Params& p, int u, char* smem) {
  int tid = threadIdx.x;
  asm volatile("" : "+v"(tid));
  const int kb = u & 7, bk = u >> 3;
  const float* ck = p.cache_k + ((size_t)bk * 512 + kb * 64) * 64;
  const float* cv = p.cache_v + ((size_t)bk * 512 + kb * 64) * 64;
  float* t = (float*)smem;
  const int tx = tid & 15, ty = tid >> 4;
#pragma unroll
  for (int i = 0; i < 4; ++i) {
    int key = ty + 16 * i;
    float4 kv = *(const float4*)(ck + key * 64 + tx * 4);
    *(uint2*)(p.Kl + ((size_t)bk * 1536 + 1024 + kb * 64 + key) * 64 + tx * 4) = make_uint2(pack2(kv.x, kv.y), pack2(kv.z, kv.w));
    float4 v = *(const float4*)(cv + key * 64 + tx * 4);
    t[key * 65 + tx * 4 + 0] = v.x; t[key * 65 + tx * 4 + 1] = v.y; t[key * 65 + tx * 4 + 2] = v.z; t[key * 65 + tx * 4 + 3] = v.w;
  }
  __syncthreads();
  const int d = tid >> 2, kc = tid & 3;
  unsigned o[8];
#pragma unroll
  for (int j = 0; j < 8; ++j) o[j] = pack2(t[(kc * 16 + 2 * j) * 65 + d], t[(kc * 16 + 2 * j + 1) * 65 + d]);
  uint4* dst = (uint4*)(p.Vtl + ((size_t)bk * 64 + d) * 1536 + 1024 + kb * 64 + kc * 16);
  dst[0] = make_uint4(o[0], o[1], o[2], o[3]);
  dst[1] = make_uint4(o[4], o[5], o[6], o[7]);
  __syncthreads();
}

#define ACT_STRIDE 528
#define RAW_OFF (32 * ACT_STRIDE)
#define RAW_STRIDE 1552
#define SMEM_BYTES (3 * 16 * 384 * 4 + 64)
DI void ld4bf_lds(const char* p, float (&o)[4]) {
  uint2 v = *(const uint2*)p;
  o[0] = bflo(v.x); o[1] = bfhi(v.x); o[2] = bflo(v.y); o[3] = bfhi(v.y);
}
DI void conv4_lds(const char* center, int boff, const float* cw, int cwcol, float (&o)[4]) {
  float c0[4], c1[4], c2[4];
  ld4bf_lds(center - RAW_STRIDE + boff, c0);
  ld4bf_lds(center + boff, c1);
  ld4bf_lds(center + RAW_STRIDE + boff, c2);
  float4 w0 = *(const float4*)(cw + cwcol), w1 = *(const float4*)(cw + 1792 + cwcol), w2 = *(const float4*)(cw + 2 * 1792 + cwcol);
  o[0] = c0[0] * w0.x + c1[0] * w1.x + c2[0] * w2.x;
  o[1] = c0[1] * w0.y + c1[1] * w1.y + c2[1] * w2.y;
  o[2] = c0[2] * w0.z + c1[2] * w1.z + c2[2] * w2.z;
  o[3] = c0[3] * w0.w + c1[3] * w1.w + c2[3] * w2.w;
}

DI void rwkv_prep_unit(const Params& p, int u, char* smem) {
  int tid = threadIdx.x;
  asm volatile("" : "+v"(tid));
  const int lane = tid & 63, wave = tid >> 6;
  const int tile = u >> 1, hg = u & 1;
  const int tok0 = tile * 32;
  int seq_start, L;
  if (tok0 < 4096) { seq_start = tok0 & ~255; L = 256; } else { seq_start = 4096 + ((tok0 - 4096) & ~1023); L = 1024; }
  const int seq_end = seq_start + L;
  {
    uint4 rg[13];
#pragma unroll
    for (int i = 0; i < 13; ++i) {
      const int idx = tid + 256 * i;
      const int row = idx / 96, rem = idx - row * 96;
      const int arr = rem >> 5, q = rem & 31;
      const int tk = tok0 - 1 + row;
      rg[i] = make_uint4(0, 0, 0, 0);
      if (idx < 34 * 96 && tk >= seq_start && tk < seq_end)
        rg[i] = *(const uint4*)(p.projA + (size_t)tk * 2560 + 768 + arr * 512 + hg * 256 + q * 8);
    }
    const int col = tid;
    const int pc = 2304 + col;
    const float w0 = p.rwkv_conv[1536 + col], w1 = p.rwkv_conv[1792 + 1536 + col], w2 = p.rwkv_conv[2 * 1792 + 1536 + col];
    float xv[18];
#pragma unroll
    for (int i = 0; i < 18; ++i) {
      const int tk = tok0 - 1 + i;
      xv[i] = (tk >= seq_start && tk < seq_end) ? bf2f(p.projA[(size_t)tk * 2560 + pc]) : 0.f;
    }
#pragma unroll
    for (int i = 0; i < 13; ++i) {
      const int idx = tid + 256 * i;
      const int row = idx / 96, rem = idx - row * 96;
      if (idx < 34 * 96) *(uint4*)(smem + RAW_OFF + row * RAW_STRIDE + rem * 16) = rg[i];
    }
#pragma unroll 1
    for (int half = 0; half < 2; ++half) {
      float xn[18];
      if (half == 0) {
#pragma unroll
        for (int i = 0; i < 18; ++i) {
          const int tk = tok0 + 15 + i;
          xn[i] = (tk >= seq_start && tk < seq_end) ? bf2f(p.projA[(size_t)tk * 2560 + pc]) : 0.f;
        }
      }
#pragma unroll
      for (int i = 0; i < 16; ++i) {
        float v = xv[i] * w0 + xv[i + 1] * w1 + xv[i + 2] * w2;
        if (col < 64) v = 1.f - 2.f * __builtin_amdgcn_rcpf(__expf(2.f * v) + 1.f);
        else if (col >= 128) v = sigmoidf_(v);
        *(bf16_t*)(smem + (half * 16 + i) * ACT_STRIDE + col * 2) = f2bf(v);
      }
      if (half == 0) {
#pragma unroll
        for (int i = 0; i < 18; ++i) xv[i] = xn[i];
      }
    }
  }
  __syncthreads();
  const int hd = hg * 4 + wave;
  const int n = lane & 31, hh = lane >> 5;
  const int tok = tok0 + n;
  const char* actrow = smem + n * ACT_STRIDE;
  const char* center = smem + RAW_OFF + (n + 1) * RAW_STRIDE;
  const int hb = wave * 128;
  float ss = 0.f;
#pragma unroll 1
  for (int tl = 0; tl < 2; ++tl)
#pragma unroll
    for (int g = 0; g < 4; ++g) {
      int c64 = tl * 32 + 8 * g + 4 * hh;
      int ch = hd * 64 + c64;
      float kc[4];
      conv4_lds(center, 512 + hb + c64 * 2, p.rwkv_conv, 512 + ch, kc);
      float4 kkw = *(const float4*)(p.k_k + ch);
      float a0 = kc[0] * kkw.x, a1 = kc[1] * kkw.y, a2 = kc[2] * kkw.z, a3 = kc[3] * kkw.w;
      ss += a0 * a0 + a1 * a1 + a2 * a2 + a3 * a3;
    }
  ss += __shfl_xor(ss, 32);
  const float kkinv = rsqrtf(ss + 1e-12f);
  {
    f32x16 ag[2];
#pragma unroll
    for (int tl = 0; tl < 2; ++tl)
#pragma unroll
      for (int r = 0; r < 16; ++r) ag[tl][r] = 0.f;
#pragma unroll
    for (int ks = 0; ks < 8; ++ks) {
      bf16x8 bfr = *(const bf16x8*)(actrow + (128 + ks * 16 + hh * 8) * 2);
#pragma unroll
      for (int tl = 0; tl < 2; ++tl) {
        bf16x8 af = *(const bf16x8*)(p.wt_g2 + (size_t)(hd * 64 + tl * 32 + n) * 128 + ks * 16 + hh * 8);
        ag[tl] = MFMA(af, bfr, ag[tl]);
      }
    }
#pragma unroll
    for (int tl = 0; tl < 2; ++tl)
#pragma unroll
      for (int g = 0; g < 4; ++g) {
        nt_store2(p.gbuf + Gidx(tok, hd, tl * 8 + 2 * g + hh), pack2(ag[tl][4 * g], ag[tl][4 * g + 1]), pack2(ag[tl][4 * g + 2], ag[tl][4 * g + 3]));
      }
  }
  float bs0 = 0.f, bs1 = 0.f;
#pragma unroll 1
  for (int tl = 0; tl < 2; ++tl) {
    unsigned kcp[8], rp[8], kkp[8];
#pragma unroll
    for (int g = 0; g < 4; ++g) {
      asm volatile("" ::: "memory");
      int c64 = tl * 32 + 8 * g + 4 * hh;
      int ch = hd * 64 + c64;
      float r4[4], k4[4], v4[4];
      conv4_lds(center, hb + c64 * 2, p.rwkv_conv, ch, r4);
      conv4_lds(center, 512 + hb + c64 * 2, p.rwkv_conv, 512 + ch, k4);
      conv4_lds(center, 1024 + hb + c64 * 2, p.rwkv_conv, 1024 + ch, v4);
      float4 kkw = *(const float4*)(p.k_k + ch);
      const float kkwv[4] = {kkw.x, kkw.y, kkw.z, kkw.w};
      kcp[2 * g] = pack2(k4[0], k4[1]); kcp[2 * g + 1] = pack2(k4[2], k4[3]);
      rp[2 * g] = pack2(r4[0], r4[1]); rp[2 * g + 1] = pack2(r4[2], r4[3]);
      kkp[2 * g] = pack2(k4[0] * kkwv[0] * kkinv, k4[1] * kkwv[1] * kkinv);
      kkp[2 * g + 1] = pack2(k4[2] * kkwv[2] * kkinv, k4[3] * kkwv[3] * kkinv);
      const int c4g = c64 >> 2;
      nt_store2(p.SH + SHidx(tok, hd, 0, c4g), rp[2 * g], rp[2 * g + 1]);
      nt_store2(p.SH + SHidx(tok, hd, 1, c4g), pack2(v4[0], v4[1]), pack2(v4[2], v4[3]));
      nt_store2(p.SH + SHidx(tok, hd, 2, c4g), kkp[2 * g], kkp[2 * g + 1]);
    }
#pragma unroll 1
    for (int d = 0; d < 2; ++d) {
      f32x16 aw, aa;
#pragma unroll
      for (int r = 0; r < 16; ++r) { aw[r] = 0.f; aa[r] = 0.f; }
#pragma unroll
      for (int ks = 0; ks < 4; ++ks) {
        bf16x8 bw = *(const bf16x8*)(actrow + (ks * 16 + hh * 8) * 2);
        bf16x8 ba = *(const bf16x8*)(actrow + (64 + ks * 16 + hh * 8) * 2);
        bf16x8 fw = *(const bf16x8*)(p.wt_w2 + (size_t)(d * 512 + hd * 64 + tl * 32 + n) * 64 + ks * 16 + hh * 8);
        bf16x8 fa = *(const bf16x8*)(p.wt_a2 + (size_t)(d * 512 + hd * 64 + tl * 32 + n) * 64 + ks * 16 + hh * 8);
        aw = MFMA(fw, bw, aw);
        aa = MFMA(fa, ba, aa);
      }
      float bsum = 0.f;
#pragma unroll
      for (int g = 0; g < 4; ++g) {
        asm volatile("" ::: "memory");
        int c64 = tl * 32 + 8 * g + 4 * hh;
        int ch = hd * 64 + c64;
        float4 w0v = *(const float4*)(p.w0 + d * 512 + ch);
        float4 a0v = *(const float4*)(p.a0 + d * 512 + ch);
        float4 kav = *(const float4*)(p.k_a + ch);
        float4 rkv = *(const float4*)(p.r_k + ch);
        const float w0a[4] = {w0v.x, w0v.y, w0v.z, w0v.w}, a0a[4] = {a0v.x, a0v.y, a0v.z, a0v.w};
        const float kaa[4] = {kav.x, kav.y, kav.z, kav.w}, rka[4] = {rkv.x, rkv.y, rkv.z, rkv.w};
        float wv[4], kdv[4], bv[4];
#pragma unroll
        for (int i = 0; i < 4; ++i) {
          int r = 4 * g + i;
          wv[i] = __expf(-0.60653065971263342f * sigmoidf_(w0a[i] + aw[r]));
          float a = sigmoidf_(a0a[i] + aa[r]);
          const unsigned kkw_ = kkp[2 * g + (i >> 1)], rw_ = rp[2 * g + (i >> 1)], kcw_ = kcp[2 * g + (i >> 1)];
          kdv[i] = ((i & 1) ? bfhi(kcw_) : bflo(kcw_)) * (1.f + (a - 1.f) * kaa[i]);
          bv[i] = ((i & 1) ? bfhi(kkw_) : bflo(kkw_)) * a;
          bsum += ((i & 1) ? bfhi(rw_) : bflo(rw_)) * kdv[i] * rka[i];
        }
        const int c4g = c64 >> 2;
        nt_store4f(p.DW + DWidx(d, tok, hd, c4g), wv[0], wv[1], wv[2], wv[3]);
        nt_store2(p.DK + DKidx(d, tok, hd, 0, c4g), pack2(kdv[0], kdv[1]), pack2(kdv[2], kdv[3]));
        nt_store2(p.DK + DKidx(d, tok, hd, 1, c4g), pack2(bv[0], bv[1]), pack2(bv[2], bv[3]));
      }
      if (d == 0) bs0 += bsum; else bs1 += bsum;
    }
  }
  bs0 += __shfl_xor(bs0, 32);
  bs1 += __shfl_xor(bs1, 32);
  if (hh == 0) *(float2*)(p.BS + BSidx(tok, hd)) = make_float2(bs0, bs1);
  __syncthreads();
}

#define SCH 16
#define SBUF (SCH * 384)
DI void ld8(const float* p, f32x2 (&o)[4]) {
  float4 t0 = *(const float4*)p, t1 = *(const float4*)(p + 4);
  o[0] = f32x2{t0.x, t0.y}; o[1] = f32x2{t0.z, t0.w}; o[2] = f32x2{t1.x, t1.y}; o[3] = f32x2{t1.z, t1.w};
}
DI float dot8(const f32x2 (&a)[4], const f32x2 (&b)[4]) {
  f32x2 p = a[0] * b[0] + a[1] * b[1];
  f32x2 q = a[2] * b[2] + a[3] * b[3];
  p = p + q;
  return p.x + p.y;
}
DI void scan_unit(const Params& p, int tok0, int L, int hd, int d, int rh, const float* s0, float* sout, char* smem) {
  const int tid = threadIdx.x;
  const int row = rh * 32 + (tid >> 3), seg = tid & 7;
  f32x2 S[4];
  if (s0) {
    ld8(s0 + row * 64 + seg * 8, S);
  } else {
#pragma unroll
    for (int j = 0; j < 4; ++j) S[j] = f32x2{0.f, 0.f};
  }
  float* buf = (float*)smem;
  const int nchunk = L / SCH;
  struct Stg { uint2 a[2], b[2], k[2]; uint4 w[2]; };
  Stg G0, G1;
#pragma unroll
  for (int q = 0; q < 2; ++q) { G0.a[q] = G0.b[q] = G0.k[q] = make_uint2(0, 0); G0.w[q] = make_uint4(0, 0, 0, 0); }
  G1 = G0;
  const int s_jt = tid & 7, s_g = (tid >> 3) & 15, s_hi = tid >> 7;
  auto gload = [&](int c, Stg& r) {
#pragma unroll
    for (int q = 0; q < 2; ++q) {
      const int tk = tok0 + (d == 0 ? c * SCH : L - SCH - c * SCH) + s_jt + 8 * q;
      r.a[q] = *(const uint2*)(p.SH + SHidx(tk, hd, s_hi, s_g));
      r.k[q] = *(const uint2*)(p.DK + DKidx(d, tk, hd, s_hi, s_g));
      if (s_hi == 0) r.b[q] = *(const uint2*)(p.SH + SHidx(tk, hd, 2, s_g));
      else r.w[q] = *(const uint4*)(p.DW + DWidx(d, tk, hd, s_g));
    }
  };
  auto put4 = [&](float* dst, uint2 v) { *(float4*)dst = make_float4(bflo(v.x), bfhi(v.x), bflo(v.y), bfhi(v.y)); };
  auto swrite = [&](int b, const Stg& r) {
#pragma unroll
    for (int q = 0; q < 2; ++q) {
      const int jt = s_jt + 8 * q;
      float* bb = buf + b * SBUF + ((d == 0) ? jt : SCH - 1 - jt) * 384 + s_g * 4;
      put4(bb + (s_hi == 0 ? 4 : 5) * 64, r.a[q]);
      put4(bb + (s_hi == 0 ? 3 : 2) * 64, r.k[q]);
      if (s_hi == 0) put4(bb, r.b[q]);
      else *(uint4*)(bb + 64) = r.w[q];
    }
  };
  gload(0, G0);
  gload(1, G1);
  swrite(0, G0);
  swrite(1, G1);
  if (2 < nchunk) gload(2, G0);
  __syncthreads();
  float sa;
  {
    f32x2 k0[4];
    ld8(buf + seg * 8, k0);
    sa = -red8(dot8(S, k0));
  }
  float ykeep = 0.f, ykeep2 = 0.f;
  int b0 = 0, b1 = 1, b2 = 2;
  auto chunk_body = [&](int c, Stg& iS, const Stg& wS) {
    const bool more2 = (c + 2 < nchunk);
    if (c + 3 < nchunk) gload(c + 3, iS);
    const float* cb = buf + b0 * SBUF + seg * 8;
    const float* nbp = (c + 1 < nchunk) ? buf + b1 * SBUF + seg * 8 : cb + (SCH - 1) * 384;
    const float* vrow = buf + b0 * SBUF + 320 + row;
    f32x2 w[4], bb[4], kd[4], r[4], kn[4];
    float vv;
    ld8(cb + 64, w); ld8(cb + 192, kd); ld8(cb + 384, kn); ld8(cb + 128, bb); ld8(cb + 256, r);
    vv = vrow[0];
#pragma unroll
    for (int i = 0; i < SCH; ++i) {
      asm volatile("" ::: "memory");
      f32x2 nw[4], nbb[4], nkd[4], nr[4], nkn[4];
      float nvv = 0.f;
      if (i < SCH - 1) {
        const float* st = cb + (i + 1) * 384;
        ld8(st + 64, nw); ld8(st + 192, nkd);
        ld8((i + 1 < SCH - 1) ? st + 384 : nbp, nkn);
        ld8(st + 128, nbb); ld8(st + 256, nr);
        nvv = vrow[(i + 1) * 384];
      }
      const f32x2 vv2 = {vv, vv};
      f32x2 U[4];
#pragma unroll
      for (int j = 0; j < 4; ++j) U[j] = S[j] * w[j] + vv2 * kd[j];
      const float Ap = dot8(U, kn), Bp = dot8(bb, kn);
      const f32x2 sa2 = {sa, sa};
#pragma unroll
      for (int j = 0; j < 4; ++j) S[j] = U[j] + sa2 * bb[j];
      const float yv = red8(dot8(S, r));
      sa = -red8(Ap + sa * Bp);
      if (seg == (i & 7)) { if (i < 8) ykeep = yv; else ykeep2 = yv; }
      if (i < SCH - 1) {
#pragma unroll
        for (int j = 0; j < 4; ++j) { w[j] = nw[j]; bb[j] = nbb[j]; kd[j] = nkd[j]; r[j] = nr[j]; kn[j] = nkn[j]; }
        vv = nvv;
      }
    }
#pragma unroll
    for (int q = 0; q < 2; ++q) {
      const int ii = c * SCH + seg + 8 * q;
      const int tt = (d == 0) ? ii : (L - 1 - ii);
      p.Y[((size_t)d * NTOK + tok0 + tt) * 512 + hd * 64 + row] = q ? ykeep2 : ykeep;
    }
    if (more2) swrite(b2, wS);
    __syncthreads();
    const int t_ = b0; b0 = b1; b1 = b2; b2 = t_;
  };
#pragma unroll 1
  for (int c = 0; c < nchunk; c += 2) {
    chunk_body(c + 0, G1, G0);
    chunk_body(c + 1, G0, G1);
  }
  if (sout) {
    *(float4*)(sout + row * 64 + seg * 8) = make_float4(S[0].x, S[0].y, S[1].x, S[1].y);
    *(float4*)(sout + row * 64 + seg * 8 + 4) = make_float4(S[2].x, S[2].y, S[3].x, S[3].y);
  }
}

#define KV_STRIDE 144
DI void attn_unit(const bf16_t* __restrict__ Q, const bf16_t* __restrict__ Kb, const bf16_t* __restrict__ Vt, int LK, bf16_t* __restrict__ O, char* smem) {
  const int tid = threadIdx.x, lane = tid & 63, wave = tid >> 6;
  const int n = lane & 31, hh = lane >> 5;
  char* Ks = smem;
  char* Vs = smem + 64 * KV_STRIDE;
  bf16x8 qf[4];
#pragma unroll
  for (int ks = 0; ks < 4; ++ks) qf[ks] = *(const bf16x8*)(Q + (size_t)(wave * 32 + n) * 64 + ks * 16 + hh * 8);
  f32x16 ot[2];
#pragma unroll
  for (int dt = 0; dt < 2; ++dt)
#pragma unroll
    for (int r = 0; r < 16; ++r) ot[dt][r] = 0.f;
  float mrun = -1e30f, lrun = 0.f;
  const int ntile = LK >> 6;
  const int lrow = tid >> 3, lc = tid & 7;
  uint4 rk0, rk1, rv0, rv1;
  rk0 = *(const uint4*)(Kb + (size_t)(lrow) * 64 + lc * 8);
  rk1 = *(const uint4*)(Kb + (size_t)(lrow + 32) * 64 + lc * 8);
  rv0 = *(const uint4*)(Vt + (size_t)(lrow) * LK + lc * 8);
  rv1 = *(const uint4*)(Vt + (size_t)(lrow + 32) * LK + lc * 8);
  for (int kt = 0; kt < ntile; ++kt) {
    *(uint4*)(Ks + (lrow) * KV_STRIDE + lc * 16) = rk0;
    *(uint4*)(Ks + (lrow + 32) * KV_STRIDE + lc * 16) = rk1;
    *(uint4*)(Vs + (lrow) * KV_STRIDE + lc * 16) = rv0;
    *(uint4*)(Vs + (lrow + 32) * KV_STRIDE + lc * 16) = rv1;
    __syncthreads();
    if (kt + 1 < ntile) {
      rk0 = *(const uint4*)(Kb + (size_t)((kt + 1) * 64 + lrow) * 64 + lc * 8);
      rk1 = *(const uint4*)(Kb + (size_t)((kt + 1) * 64 + lrow + 32) * 64 + lc * 8);
      rv0 = *(const uint4*)(Vt + (size_t)(lrow) * LK + (kt + 1) * 64 + lc * 8);
      rv1 = *(const uint4*)(Vt + (size_t)(lrow + 32) * LK + (kt + 1) * 64 + lc * 8);
    }
    f32x16 st[2];
#pragma unroll
    for (int kb = 0; kb < 2; ++kb) {
#pragma unroll
      for (int r = 0; r < 16; ++r) st[kb][r] = 0.f;
#pragma unroll
      for (int ks = 0; ks < 4; ++ks) {
        bf16x8 af = *(const bf16x8*)(Ks + (kb * 32 + n) * KV_STRIDE + (ks * 2 + hh) * 16);
        st[kb] = MFMA(af, qf[ks], st[kb]);
      }
    }
    float mx = st[0][0];
#pragma unroll
    for (int kb = 0; kb < 2; ++kb)
#pragma unroll
      for (int r = 0; r < 16; ++r) mx = fmaxf(mx, st[kb][r]);
    mx = fmaxf(mx, __shfl_xor(mx, 32));
    const float mnew = fmaxf(mrun, mx);
    const float alpha = __builtin_amdgcn_exp2f(mrun - mnew);
    mrun = mnew;
    float ps = 0.f;
#pragma unroll
    for (int kb = 0; kb < 2; ++kb)
#pragma unroll
      for (int r = 0; r < 16; ++r) { float e = __builtin_amdgcn_exp2f(st[kb][r] - mnew); st[kb][r] = e; ps += e; }
    lrun = lrun * alpha + ps;
#pragma unroll
    for (int dt = 0; dt < 2; ++dt)
#pragma unroll
      for (int r = 0; r < 16; ++r) ot[dt][r] *= alpha;
#pragma unroll
    for (int kb = 0; kb < 2; ++kb)
#pragma unroll
      for (int s = 0; s < 2; ++s) {
        uint4 pk = make_uint4(pack2(st[kb][8 * s + 0], st[kb][8 * s + 1]), pack2(st[kb][8 * s + 2], st[kb][8 * s + 3]),
                              pack2(st[kb][8 * s + 4], st[kb][8 * s + 5]), pack2(st[kb][8 * s + 6], st[kb][8 * s + 7]));
        bf16x8 pf = __builtin_bit_cast(bf16x8, pk);
#pragma unroll
        for (int dt = 0; dt < 2; ++dt) {
          const char* vp = Vs + (dt * 32 + n) * KV_STRIDE + (kb * 32 + 16 * s + 4 * hh) * 2;
          uint2 lo = *(const uint2*)(vp), hi = *(const uint2*)(vp + 16);
          bf16x8 vf = __builtin_bit_cast(bf16x8, make_uint4(lo.x, lo.y, hi.x, hi.y));
          ot[dt] = MFMA(vf, pf, ot[dt]);
        }
      }
    __syncthreads();
  }
  lrun += __shfl_xor(lrun, 32);
  const float inv = 1.f / lrun;
#pragma unroll
  for (int dt = 0; dt < 2; ++dt)
#pragma unroll
    for (int g = 0; g < 4; ++g) {
      int dd = dt * 32 + 8 * g + 4 * hh;
      *(uint2*)(O + (size_t)(wave * 32 + n) * 512 + dd) =
          make_uint2(pack2(ot[dt][4 * g] * inv, ot[dt][4 * g + 1] * inv), pack2(ot[dt][4 * g + 2] * inv, ot[dt][4 * g + 3] * inv));
    }
}

DI void phase4(const Params& p, int u, char* smem) {
  if (u < 128) {
    const int scan = u >> 1, rh = u & 1;
    const int b = scan >> 4, hd = (scan >> 1) & 7, d = scan & 1;
    scan_unit(p, 4096 + b * 1024, 1024, hd, d, rh, p.state + ((size_t)(b * 2 + d) * 8 + hd) * 4096, nullptr, smem);
  } else if (u < 256) {
#pragma unroll 1
    for (int j = 0; j < 4; ++j) {
      const int cu = (u - 128) * 4 + j;
      const int scan = cu >> 1, rh = cu & 1;
      const int s = scan >> 4, hd = (scan >> 1) & 7, d = scan & 1;
      scan_unit(p, s * 256, 256, hd, d, rh, nullptr, p.out + (size_t)2 * 4194304 + 2 * 524288 + ((size_t)(s * 2 + d) * 8 + hd) * 4096, smem);
    }
  } else {
    const int a = u - 256;
    {
      const int qb = a & 7, hd = (a >> 3) & 7, b = a >> 6;
      const int kvh = hd >> 2;
      attn_unit(p.q + (size_t)4096 * 512 + ((size_t)(b * 8 + hd) * 1024 + qb * 128) * 64, p.Kl + (size_t)(b * 2 + kvh) * 1536 * 64,
                p.Vtl + (size_t)(b * 2 + kvh) * 64 * 1536, 1536, p.attn_o + (size_t)(4096 + b * 1024 + qb * 128) * 512 + hd * 64, smem);
    }
    {
      const int qb = a & 1, hd = (a >> 1) & 7, s = a >> 4;
      const int kvh = hd >> 2;
      attn_unit(p.q + ((size_t)(s * 8 + hd) * 256 + qb * 128) * 64, p.Kc + (size_t)(s * 2 + kvh) * 256 * 64,
                p.Vtc + (size_t)(s * 2 + kvh) * 64 * 256, 256, p.attn_o + (size_t)(s * 256 + qb * 128) * 512 + hd * 64, smem);
    }
  }
}

DI void rwkv_final_tok4(const Params& p, int tok0) {
  const int lane = threadIdx.x & 63;
  const int hd = lane >> 3, sub = lane & 7;
  const int ch = hd * 64 + sub * 8;
  float4 ya[4][2], yb[4][2];
#pragma unroll
  for (int t = 0; t < 4; ++t) {
    const float* y0 = p.Y + (size_t)(tok0 + t) * 512 + ch;
    const float* y1 = p.Y + ((size_t)NTOK + tok0 + t) * 512 + ch;
    ya[t][0] = *(const float4*)y0; ya[t][1] = *(const float4*)(y0 + 4);
    yb[t][0] = *(const float4*)y1; yb[t][1] = *(const float4*)(y1 + 4);
  }
  uint4 vr[2][2], gr[2][2];
#pragma unroll
  for (int c = 0; c < 2; ++c) {
    const uint4* vp = (const uint4*)(p.SH + SHidx(tok0, hd, 1, sub * 2 + c));
    const uint4* gp = (const uint4*)(p.gbuf + Gidx(tok0, hd, sub * 2 + c));
    vr[c][0] = vp[0]; vr[c][1] = vp[1];
    gr[c][0] = gp[0]; gr[c][1] = gp[1];
  }
  float2 bsv[4];
#pragma unroll
  for (int t = 0; t < 4; ++t) bsv[t] = *(const float2*)(p.BS + BSidx(tok0 + t, hd));
  float4 lg0 = *(const float4*)(p.ln_g + ch), lg1 = *(const float4*)(p.ln_g + ch + 4);
  float4 lb0 = *(const float4*)(p.ln_b + ch), lb1 = *(const float4*)(p.ln_b + ch + 4);
  const float lg[8] = {lg0.x, lg0.y, lg0.z, lg0.w, lg1.x, lg1.y, lg1.z, lg1.w};
  const float lb[8] = {lb0.x, lb0.y, lb0.z, lb0.w, lb1.x, lb1.y, lb1.z, lb1.w};
#pragma unroll
  for (int t = 0; t < 4; ++t) {
    float y[8] = {ya[t][0].x + yb[t][0].x, ya[t][0].y + yb[t][0].y, ya[t][0].z + yb[t][0].z, ya[t][0].w + yb[t][0].w,
                  ya[t][1].x + yb[t][1].x, ya[t][1].y + yb[t][1].y, ya[t][1].z + yb[t][1].z, ya[t][1].w + yb[t][1].w};
    float s = 0.f;
#pragma unroll
    for (int j = 0; j < 8; ++j) s += y[j];
    const float mu = red8(s) * (1.f / 64.f);
    float vs = 0.f;
#pragma unroll
    for (int j = 0; j < 8; ++j) { y[j] -= mu; vs += y[j] * y[j]; }
    const float rstd = rsqrtf(red8(vs) * (1.f / 64.f) + 64e-5f);
    const float bsum = bsv[t].x + bsv[t].y;
    unsigned vw[4], gw[4];
#pragma unroll
    for (int c = 0; c < 2; ++c) {
      const uint4 vq = vr[c][t >> 1], gq = gr[c][t >> 1];
      vw[2 * c] = (t & 1) ? vq.z : vq.x; vw[2 * c + 1] = (t & 1) ? vq.w : vq.y;
      gw[2 * c] = (t & 1) ? gq.z : gq.x; gw[2 * c + 1] = (t & 1) ? gq.w : gq.y;
    }
    const float vv[8] = {bflo(vw[0]), bfhi(vw[0]), bflo(vw[1]), bfhi(vw[1]), bflo(vw[2]), bfhi(vw[2]), bflo(vw[3]), bfhi(vw[3])};
    const float gg[8] = {bflo(gw[0]), bfhi(gw[0]), bflo(gw[1]), bfhi(gw[1]), bflo(gw[2]), bfhi(gw[2]), bflo(gw[3]), bfhi(gw[3])};
    float o[8];
#pragma unroll
    for (int j = 0; j < 8; ++j) o[j] = (y[j] * rstd * lg[j] + lb[j] + bsum * vv[j]) * gg[j];
    *(uint4*)(p.rwkv_o + (size_t)(tok0 + t) * 512 + ch) = make_uint4(pack2(o[0], o[1]), pack2(o[2], o[3]), pack2(o[4], o[5]), pack2(o[6], o[7]));
  }
}

DI void unpack8(uint4 v, float (&o)[8]) {
  o[0] = bflo(v.x); o[1] = bfhi(v.x); o[2] = bflo(v.y); o[3] = bfhi(v.y); o[4] = bflo(v.z); o[5] = bfhi(v.z); o[6] = bflo(v.w); o[7] = bfhi(v.w);
}
DI void ffn_act_unit(const Params& p, int u) {
  const int item = u * 256 + threadIdx.x;
  const int er = item / 2816, chn = item - er * 2816;
  const int blk = er >> 1, last = er & 1;
  const bool firstblk = blk < 32 ? ((blk & 1) == 0) : (((blk - 32) & 7) == 0);
  const bool lastblk = blk < 32 ? ((blk & 1) == 1) : (((blk - 32) & 7) == 7);
  const bf16_t* e = p.edge + (size_t)blk * 4 * 5632;
  float pu = 0.f, pg = 0.f, cu, cg, nu = 0.f, ng = 0.f;
  if (!last) {
    if (!firstblk) { pu = bf2f(e[-5632 + chn]); pg = bf2f(e[-5632 + 2816 + chn]); }
    cu = bf2f(e[chn]); cg = bf2f(e[2816 + chn]);
    nu = bf2f(e[5632 + chn]); ng = bf2f(e[5632 + 2816 + chn]);
  } else {
    pu = bf2f(e[2 * 5632 + chn]); pg = bf2f(e[2 * 5632 + 2816 + chn]);
    cu = bf2f(e[3 * 5632 + chn]); cg = bf2f(e[3 * 5632 + 2816 + chn]);
    if (!lastblk) { nu = bf2f(e[4 * 5632 + chn]); ng = bf2f(e[4 * 5632 + 2816 + chn]); }
  }
  const float uu = pu * p.ffn_conv[chn] + cu * p.ffn_conv[5632 + chn] + nu * p.ffn_conv[2 * 5632 + chn];
  const float gg = pg * p.ffn_conv[2816 + chn] + cg * p.ffn_conv[5632 + 2816 + chn] + ng * p.ffn_conv[2 * 5632 + 2816 + chn];
  p.act[(size_t)(blk * 128 + (last ? 127 : 0)) * 2816 + chn] = f2bf(gg * sigmoidf_(gg) * uu);
}

#define NPHASE 13
template <int PH> DI void run_phase(const Params& p, char* smem) {
  const int nb = gridDim.x;
  if (PH == 0) for (int u = blockIdx.x; u < P0_MOD_UNITS; u += nb) phase0(p, u, smem);
  if (PH == 1) for (int u = blockIdx.x; u < 512 + (P0_UNITS - P0_MOD_UNITS); u += nb) {
    if (u < 512) norm_rows<0>(p, u);
    else phase0(p, u - 512 + P0_MOD_UNITS, smem);
  }
  if (PH == 2) for (int u = blockIdx.x; u < 32 * 32 + 64 * 4; u += nb) {
    if (u < 1024) gemm_unit_wide<0>(p, u & 31, u >> 5, smem);
    else gemm_unit<0>(p, (u - 1024) + 64 * 32, smem);
  }
  if (PH == 3) for (int u = blockIdx.x; u < 512 + 512 + 64 + 256; u += nb) {
    if (u < 512) rwkv_prep_unit(p, u, smem);
    else if (u < 1024) attn_prep_unit(p, u - 512);
    else if (u < 1024 + 64) cache_conv_unit(p, u - 1024, smem);
    else v_prep_unit(p, u - 1088);
  }
  if (PH == 4) for (int u = blockIdx.x; u < 512; u += nb) phase4(p, u, smem);
  if (PH == 5) for (int u = blockIdx.x; u < 512; u += nb) rwkv_final_tok4(p, u * 16 + (threadIdx.x >> 6) * 4);
  if (PH == 6) {
#pragma unroll 1
    for (int u = blockIdx.x; u < 64 * 8; u += nb) gemm_unit<1>(p, u, smem);
    asm volatile("" ::: "memory");
#pragma unroll 1
    for (int u = blockIdx.x; u < 64 * 8; u += nb) gemm_unit<5>(p, u, smem);
  }
  if (PH == 7) for (int u = blockIdx.x; u < 64 * 8; u += nb) gemm_unit<2>(p, u, smem);
  if (PH == 8) for (int u = blockIdx.x; u < 512; u += nb) norm_rows<1>(p, u);
  if (PH == 9) for (int u = blockIdx.x; u < 32 * 44; u += nb) gemm_unit_wide<3>(p, u & 31, u >> 5, smem);
  if (PH == 10) for (int u = blockIdx.x; u < 1408; u += nb) ffn_act_unit(p, u);
  if (PH == 11) for (int u = blockIdx.x; u < 64 * 8; u += nb) gemm_unit<4>(p, u, smem);
  if (PH == 12) for (int u = blockIdx.x; u < 512; u += nb) norm_rows<2>(p, u);
}


#define XB_TMO      128
#define XB_XCNT(j)  (256  + 64 * (j))
#define XB_XSUB(j)  (1280 + 64 * (j))
#define XB_XGEN(j)  (2304 + 64 * (j))
#define XB_TOP      3328
#define XB_TOPGEN   3392
#define XCD_BAR_WORDS 3456
#define XB_SPIN_CAP (1u << 18)
#define LAS __attribute__((address_space(3)))

__device__ __forceinline__ unsigned xb_ld(unsigned* p)              { return __hip_atomic_load(p, __ATOMIC_RELAXED, __HIP_MEMORY_SCOPE_AGENT); }
__device__ __forceinline__ unsigned xb_add(unsigned* p, unsigned v) { return __hip_atomic_fetch_add(p, v, __ATOMIC_RELAXED, __HIP_MEMORY_SCOPE_AGENT); }
__device__ __forceinline__ unsigned xb_xcc_id() { return (unsigned)__builtin_amdgcn_s_getreg((3 << 11) | 20) & 0xFu; }
#define XB_SPIN(cond, bar) do { unsigned _sp = 0; while (cond) { __builtin_amdgcn_s_sleep(1); \
    if ((++_sp & 255u) == 0u) { if (xb_ld(&(bar)[XB_TMO])) break; if (_sp > XB_SPIN_CAP) { atomicAdd(&(bar)[XB_TMO], 1u); break; } } } } while (0)

struct XcdBarrier {
    unsigned* bar; unsigned x;
    volatile LAS unsigned* st;
};

__device__ __forceinline__ XcdBarrier xcd_barrier_post(unsigned* bar, volatile LAS unsigned* st) {
    XcdBarrier b; b.bar = bar; b.x = xb_xcc_id(); b.st = st;
    if (threadIdx.x == 0) (void)xb_add(&bar[XB_XCNT(b.x)], 1u);
    return b;
}
__device__ __forceinline__ void xcd_barrier_complete(unsigned* bar, unsigned x, unsigned& nloc, unsigned& nx) {
    const unsigned G = gridDim.x * gridDim.y * gridDim.z;
    unsigned sum, cnt, mine, sp = 0u;
    for (;;) {
        sum = 0u; cnt = 0u; mine = 0u;
#pragma unroll
        for (unsigned j = 0; j < 16; ++j) { const unsigned c = xb_ld(&bar[XB_XCNT(j)]); sum += c; cnt += (c > 0u) ? 1u : 0u; mine = (j == x) ? c : mine; }
        if (sum == G) break;
        __builtin_amdgcn_s_sleep(1);
        if ((++sp & 255u) == 0u) { if (xb_ld(&bar[XB_TMO])) break; if (sp > XB_SPIN_CAP) { atomicAdd(&bar[XB_TMO], 1u); break; } }
    }
    nloc = mine > 0u ? mine : 1u; nx = cnt > 0u ? cnt : 1u;
}

__device__ __forceinline__ void xcd_barrier(const XcdBarrier& b) {
    asm volatile("s_waitcnt vmcnt(0)" ::: "memory");
    __syncthreads();
    if (threadIdx.x == 0) {
        unsigned* bar = b.bar;
        __builtin_amdgcn_s_waitcnt(0);
        unsigned nloc = b.st[0], nx = b.st[1];
        if (nloc == 0u) { xcd_barrier_complete(bar, b.x, nloc, nx); b.st[0] = nloc; b.st[1] = nx; }
        const unsigned old = xb_add(&bar[XB_XSUB(b.x)], 1u);
        const unsigned gen = old / nloc;
        if (old + 1u == (gen + 1u) * nloc) {
            __builtin_amdgcn_fence(__ATOMIC_RELEASE, "agent");
            asm volatile("s_waitcnt vmcnt(0)" ::: "memory");
            const unsigned og = xb_add(&bar[XB_TOP], 1u);
            const unsigned tg = og / nx;
            if (og + 1u == (tg + 1u) * nx) xb_add(&bar[XB_TOPGEN], 1u);
            else XB_SPIN(xb_ld(&bar[XB_TOPGEN]) == tg, bar);
            __builtin_amdgcn_fence(__ATOMIC_ACQUIRE, "agent");
            xb_add(&bar[XB_XGEN(b.x)], 1u);
            asm volatile("s_waitcnt vmcnt(0)" ::: "memory");
        } else {
            XB_SPIN(xb_ld(&bar[XB_XGEN(b.x)]) == gen, bar);
            __builtin_amdgcn_fence(__ATOMIC_ACQUIRE, "agent");
            asm volatile("s_waitcnt vmcnt(0)" ::: "memory");
        }
    }
    __syncthreads();
}

#if FUSED
__global__ void __launch_bounds__(256, 2) fwd_megakernel(Params p) {
  __shared__ __attribute__((aligned(16))) char smem[SMEM_BYTES];
  cg::grid_group grid = cg::this_grid();
  if (p.never) grid.sync();
  __shared__ uint4 xb_words;
  if (threadIdx.x == 0) xb_words = make_uint4(0u, 0u, 0u, 0u);
  __syncthreads();
  XcdBarrier xb = xcd_barrier_post(p.bar, (volatile LAS unsigned*)&xb_words);
#define GB() xcd_barrier(xb)
  run_phase<0>(p, smem); GB();
  run_phase<1>(p, smem); GB();
  run_phase<2>(p, smem); GB();
  run_phase<3>(p, smem); GB();
  run_phase<4>(p, smem); GB();
  run_phase<5>(p, smem); GB();
  run_phase<6>(p, smem); GB();
  run_phase<7>(p, smem); GB();
  run_phase<8>(p, smem); GB();
  run_phase<9>(p, smem); GB();
  run_phase<10>(p, smem); GB();
  run_phase<11>(p, smem); GB();
  run_phase<12>(p, smem);
}
#else
template <int PH> __global__ void __launch_bounds__(256, 2) phase_kernel(Params p) {
  __shared__ __attribute__((aligned(16))) char smem[SMEM_BYTES];
  run_phase<PH>(p, smem);
}
#endif

extern "C" void kernel_launch(void* const* d_in, const int* in_sizes, int n_in, void* d_out, int out_size, void* d_ws,
                              size_t ws_size, hipStream_t stream) {
  Params p{};
  const float** fp = (const float**)&p;
  for (int i = 0; i < 32; ++i) fp[i] = (const float*)d_in[i];
  p.out = (float*)d_out;
  char* w = (char*)d_ws;
  size_t off = 0;
  auto take = [&](size_t bytes) { char* r = w + off; off += (bytes + 255) & ~(size_t)255; return r; };
  p.mod = (float*)take(5 * 6144 * 4);
  p.wt_in = (bf16_t*)take((size_t)4608 * 1024 * 2);
  p.wt_attn = (bf16_t*)take((size_t)1024 * 512 * 2);
  p.wt_rwkv = (bf16_t*)take((size_t)1024 * 512 * 2);
  p.wt_out = (bf16_t*)take((size_t)1024 * 1024 * 2);
  p.wt_up = (bf16_t*)take((size_t)5632 * 1024 * 2);
  p.wt_down = (bf16_t*)take((size_t)1024 * 2816 * 2);
  p.wt_w2 = (bf16_t*)take((size_t)2 * 512 * 64 * 2);
  p.wt_a2 = (bf16_t*)take((size_t)2 * 512 * 64 * 2);
  p.wt_g2 = (bf16_t*)take((size_t)512 * 128 * 2);
  p.h = (bf16_t*)take((size_t)NTOK * 1024 * 2);
  p.attn_o = p.h;
  p.rwkv_o = p.h + (size_t)NTOK * 512;
  p.projA = (bf16_t*)take((size_t)NTOK * 2560 * 2);
  p.gates = (bf16_t*)take((size_t)NTOK * 2048 * 2);
  p.Y = (float*)p.projA;
  p.act = p.projA;
  p.SH = (bf16_t*)take((size_t)NTOK * 8 * 192 * 2);
  p.DW = (float*)take((size_t)2 * NTOK * 512 * 4);
  p.DK = (bf16_t*)take((size_t)2 * NTOK * 8 * 128 * 2);
  p.up = p.SH;
  p.edge = (bf16_t*)take((size_t)64 * 4 * 5632 * 2);
  p.gbuf = (bf16_t*)take((size_t)NTOK * 512 * 2);
  p.BS = (float*)take((size_t)NTOK * 8 * 2 * 4);
  p.q = (bf16_t*)take((size_t)NTOK * 512 * 2);
  p.Kc = (bf16_t*)take((size_t)16 * 2 * 256 * 64 * 2);
  p.Kl = (bf16_t*)take((size_t)4 * 2 * 1536 * 64 * 2);
  p.Vtc = (bf16_t*)take((size_t)16 * 2 * 256 * 64 * 2);
  p.Vtl = (bf16_t*)take((size_t)4 * 2 * 1536 * 64 * 2);
  p.merged = (bf16_t*)take((size_t)NTOK * 1024 * 2);
  p.bar = (unsigned*)take(XCD_BAR_WORDS * 4);
  p.never = 0;
  p.pad_ = 0;
  if (off > ws_size) { fprintf(stderr, "workspace too small: need %zu have %zu\n", off, ws_size); return; }
#if FUSED
  static int grid_blocks = 0;
  if (!grid_blocks) {
    int dev = 0, cus = 0, per_cu = 0;
    hipGetDevice(&dev);
    hipDeviceGetAttribute(&cus, hipDeviceAttributeMultiprocessorCount, dev);
    hipOccupancyMaxActiveBlocksPerMultiprocessor(&per_cu, fwd_megakernel, 256, 0);
    if (per_cu > 2) per_cu = 2;
    if (per_cu < 1) per_cu = 1;
    grid_blocks = cus * per_cu;
  }
  hipMemsetAsync(p.bar, 0, XCD_BAR_WORDS * 4, stream);
  void* args[] = {&p};
  hipError_t e = hipLaunchCooperativeKernel((void*)fwd_megakernel, dim3(grid_blocks), dim3(256), args, 0, stream);
  if (e != hipSuccess) fprintf(stderr, "cooperative launch failed: %s (grid %d)\n", hipGetErrorString(e), grid_blocks);
#else
  const int G = 1024;
  phase_kernel<0><<<G, 256, 0, stream>>>(p);
  phase_kernel<1><<<G, 256, 0, stream>>>(p);
  phase_kernel<2><<<G, 256, 0, stream>>>(p);
  phase_kernel<3><<<G, 256, 0, stream>>>(p);
  phase_kernel<4><<<512, 256, 0, stream>>>(p);
  phase_kernel<5><<<G, 256, 0, stream>>>(p);
  phase_kernel<6><<<G, 256, 0, stream>>>(p);
  phase_kernel<7><<<G, 256, 0, stream>>>(p);
  phase_kernel<8><<<G, 256, 0, stream>>>(p);
  phase_kernel<9><<<G, 256, 0, stream>>>(p);
  phase_kernel<10><<<G, 256, 0, stream>>>(p);
  phase_kernel<11><<<G, 256, 0, stream>>>(p);
  phase_kernel<12><<<G, 256, 0, stream>>>(p);
#endif
}
```

```cpp
#include <hip/hip_runtime.h>
#include <hip/hip_cooperative_groups.h>
#include <cstdio>
namespace cg = cooperative_groups;

#ifndef FUSED
#define FUSED 1
#endif

typedef unsigned short bf16_t;
typedef __attribute__((ext_vector_type(8))) short bf16x8;
typedef __attribute__((ext_vector_type(16))) float f32x16;
typedef __attribute__((ext_vector_type(2))) float f32x2;
typedef __attribute__((ext_vector_type(2))) __bf16 bf16x2_t;

#define DI __device__ __forceinline__
#define MFMA(a, b, c) __builtin_amdgcn_mfma_f32_32x32x16_bf16((a), (b), (c), 0, 0, 0)

#define NTOK 8192
#define BAR_READY (3456 + 16)
#define QSCALE 0.18033688011112042f

struct Params {
  const float *x_prompt, *x_sample, *cache_k, *cache_v, *state, *c, *c_ctx, *w_ada, *b_ada, *norm1_g, *w_in,
      *q_norm_g, *k_norm_g, *rwkv_conv, *w0, *w2, *a0, *a2, *g2, *k_k, *k_a, *r_k, *ln_g, *ln_b, *w_attn_br,
      *w_rwkv_br, *w_out, *norm2_g, *ffn_up, *ffn_conv, *ffn_down, *final_g;
  float* out;
  float* mod;
  bf16_t *wt_in, *wt_attn, *wt_rwkv, *wt_out, *wt_up, *wt_down, *wt_w2, *wt_a2, *wt_g2;
  bf16_t* h;
  bf16_t *attn_o, *rwkv_o;
  bf16_t* projA;
  bf16_t* gates;
  float* Y;
  bf16_t* act;
  bf16_t* SH;
  float* DW;
  bf16_t* DK;
  bf16_t* up;
  bf16_t* edge;
  bf16_t* gbuf;
  float* BS;
  bf16_t* q;
  bf16_t *Kc, *Kl, *Vtc, *Vtl;
  bf16_t* merged;
  unsigned* bar;
  int never;
  int pad_;
};

DI unsigned pack2(float a, float b) {
  f32x2 v = {a, b};
  bf16x2_t r = __builtin_convertvector(v, bf16x2_t);
  return __builtin_bit_cast(unsigned, r);
}
DI bf16_t f2bf(float a) { return (bf16_t)(pack2(a, 0.f) & 0xffffu); }
DI float bflo(unsigned u) { return __uint_as_float(u << 16); }
DI float bfhi(unsigned u) { return __uint_as_float(u & 0xffff0000u); }
DI float bf2f(bf16_t b) { return __uint_as_float(((unsigned)b) << 16); }

template <int CTRL> DI float dppf(float x) {
  return __int_as_float(__builtin_amdgcn_update_dpp(0, __float_as_int(x), CTRL, 0xF, 0xF, true));
}
DI float red8(float x) {
  x += dppf<0xB1>(x);
  x += dppf<0x4E>(x);
  x += dppf<0x141>(x);
  return x;
}
DI float wave_sum(float x) {
#pragma unroll
  for (int o = 32; o >= 1; o >>= 1) x += __shfl_xor(x, o);
  return x;
}
DI const float* xrow(const Params& p, int tok) {
  return tok < 4096 ? p.x_prompt + (size_t)tok * 1024 : p.x_sample + (size_t)(tok - 4096) * 1024;
}
DI int modrow(int tok) { return tok < 4096 ? 0 : 1 + ((tok - 4096) >> 10); }
DI float sigmoidf_(float x) { return __builtin_amdgcn_rcpf(1.f + __expf(-x)); }

typedef __attribute__((ext_vector_type(2))) unsigned u32x2_t;
typedef __attribute__((ext_vector_type(4))) float f32x4_t;
DI void nt_store2(void* p, unsigned a, unsigned b) { u32x2_t v = {a, b}; __builtin_nontemporal_store(v, (u32x2_t*)p); }
DI void nt_store4f(void* p, float a, float b, float c, float d) { f32x4_t v = {a, b, c, d}; __builtin_nontemporal_store(v, (f32x4_t*)p); }
DI size_t SHidx(int tok, int hd, int arr, int c4g) { return ((((size_t)(hd * 256 + (tok >> 5)) * 3 + arr) * 16 + c4g) * 32 + (tok & 31)) * 4; }
DI size_t DKidx(int d, int tok, int hd, int arr, int c4g) { return ((((size_t)((d * 8 + hd) * 256 + (tok >> 5)) * 2 + arr) * 16 + c4g) * 32 + (tok & 31)) * 4; }
DI size_t DWidx(int d, int tok, int hd, int c4g) { return (((size_t)((d * 8 + hd) * 256 + (tok >> 5)) * 16 + c4g) * 32 + (tok & 31)) * 4; }
DI size_t Gidx(int tok, int hd, int c4g) { return (((size_t)(hd * 256 + (tok >> 5)) * 16 + c4g) * 32 + (tok & 31)) * 4; }
DI size_t BSidx(int tok, int hd) { return ((size_t)hd * NTOK + tok) * 2; }

DI void transpose_tile(const float* __restrict__ W, bf16_t* __restrict__ Wt, int K, int N, int tile, char* smem, const bool ugperm = false) {
  const int tid = threadIdx.x;
  const int ntn = N >> 6;
  const int tk = tile / ntn, tn = tile - tk * ntn;
  const int k0 = tk * 64, n0 = tn * 64;
  float* t = (float*)smem;
  const int tx = tid & 15, ty = tid >> 4;
#pragma unroll
  for (int i = 0; i < 4; ++i) {
    int k = ty + 16 * i;
    float4 v = *(const float4*)(W + (size_t)(k0 + k) * N + n0 + tx * 4);
    t[k * 65 + tx * 4 + 0] = v.x; t[k * 65 + tx * 4 + 1] = v.y; t[k * 65 + tx * 4 + 2] = v.z; t[k * 65 + tx * 4 + 3] = v.w;
  }
  __syncthreads();
  const int n = tid >> 2, kc = tid & 3;
  unsigned o[8];
#pragma unroll
  for (int j = 0; j < 8; ++j) o[j] = pack2(t[(kc * 16 + 2 * j) * 65 + n], t[(kc * 16 + 2 * j + 1) * 65 + n]);
  int drow = n0 + n;
  if (ugperm) {
    const bool isg = n0 >= 2816;
    const int cc = (isg ? n0 - 2816 : n0) + n;
    drow = (cc >> 6) * 128 + ((cc >> 5) & 1) * 64 + (isg ? 32 : 0) + (cc & 31);
  }
  uint4* dst = (uint4*)(Wt + (size_t)drow * K + k0 + kc * 16);
  dst[0] = make_uint4(o[0], o[1], o[2], o[3]);
  dst[1] = make_uint4(o[4], o[5], o[6], o[7]);
  __syncthreads();
}

#define P0_MOD_UNITS 384
#define P0_UNITS (P0_MOD_UNITS + 1152 + 128 + 128 + 256 + 1408 + 704 + 16 + 16 + 16)
DI void phase0(const Params& p, int u, char* smem) {
  const int tid = threadIdx.x;
  if (u < P0_MOD_UNITS) {
    float* sc = (float*)smem;
    float* red = sc + 5 * 1024;
    for (int i = tid; i < 5 * 1024; i += 256) {
      int r = i >> 10, k = i & 1023;
      float cv = (r == 0) ? p.c_ctx[k] : p.c[(r - 1) * 1024 + k];
      sc[i] = cv / (1.f + __expf(-cv));
    }
    __syncthreads();
    const int cgp = tid & 3, kg = tid >> 2;
    const int n = u * 16 + cgp * 4;
    float4 acc[5];
#pragma unroll
    for (int r = 0; r < 5; ++r) acc[r] = make_float4(0.f, 0.f, 0.f, 0.f);
#pragma unroll
    for (int kk = 0; kk < 16; ++kk) {
      int k = kg * 16 + kk;
      float4 w = *(const float4*)(p.w_ada + (size_t)k * 6144 + n);
#pragma unroll
      for (int r = 0; r < 5; ++r) {
        float s = sc[r * 1024 + k];
        acc[r].x += s * w.x; acc[r].y += s * w.y; acc[r].z += s * w.z; acc[r].w += s * w.w;
      }
    }
#pragma unroll
    for (int r = 0; r < 5; ++r) {
      float* d = red + (kg * 5 + r) * 16 + cgp * 4;
      d[0] = acc[r].x; d[1] = acc[r].y; d[2] = acc[r].z; d[3] = acc[r].w;
    }
    __syncthreads();
    if (tid < 80) {
      int r = tid >> 4, ci = tid & 15;
      float s = p.b_ada[u * 16 + ci];
      for (int g = 0; g < 64; ++g) s += red[(g * 5 + r) * 16 + ci];
      p.mod[r * 6144 + u * 16 + ci] = s;
    }
    __syncthreads();
    return;
  }
  int t = u - P0_MOD_UNITS;
  if (t < 1152) { transpose_tile(p.w_in, p.wt_in, 1024, 4608, t, smem); return; }
  t -= 1152;
  if (t < 128) { transpose_tile(p.w_attn_br, p.wt_attn, 512, 1024, t, smem); return; }
  t -= 128;
  if (t < 128) { transpose_tile(p.w_rwkv_br, p.wt_rwkv, 512, 1024, t, smem); return; }
  t -= 128;
  if (t < 256) { transpose_tile(p.w_out, p.wt_out, 1024, 1024, t, smem); return; }
  t -= 256;
  if (t < 1408) { transpose_tile(p.ffn_up, p.wt_up, 1024, 5632, t, smem, true); return; }
  t -= 1408;
  if (t < 704) { transpose_tile(p.ffn_down, p.wt_down, 2816, 1024, t, smem); return; }
  t -= 704;
  if (t < 16) { int d = t >> 3; transpose_tile(p.w2 + d * 64 * 512, p.wt_w2 + d * 512 * 64, 64, 512, t & 7, smem); return; }
  t -= 16;
  if (t < 16) { int d = t >> 3; transpose_tile(p.a2 + d * 64 * 512, p.wt_a2 + d * 512 * 64, 64, 512, t & 7, smem); return; }
  t -= 16;
  transpose_tile(p.g2, p.wt_g2, 128, 512, t, smem);
}

template <int MODE> DI void norm_rows(const Params& p, int u) {
  const int tid = threadIdx.x, wave = tid >> 6, lane = tid & 63;
  const int tok0 = u * 16 + wave * 4;
  float4 v[4][4];
#pragma unroll
  for (int rr = 0; rr < 4; ++rr) {
    const float* xr = (MODE == 0) ? xrow(p, tok0 + rr) : p.out + (size_t)(tok0 + rr) * 1024;
#pragma unroll
    for (int i = 0; i < 4; ++i) v[rr][i] = *(const float4*)(xr + lane * 4 + 256 * i);
  }
  const float* g = (MODE == 0) ? p.norm1_g : (MODE == 1) ? p.norm2_g : p.final_g;
  float4 gg[4];
#pragma unroll
  for (int i = 0; i < 4; ++i) gg[i] = *(const float4*)(g + lane * 4 + 256 * i);
  const float* mr = p.mod + modrow(tok0) * 6144 + (MODE == 1 ? 3 * 1024 : 0);
  float4 sh[4], scl[4];
  if (MODE < 2) {
#pragma unroll
    for (int i = 0; i < 4; ++i) { sh[i] = *(const float4*)(mr + lane * 4 + 256 * i); scl[i] = *(const float4*)(mr + 1024 + lane * 4 + 256 * i); }
  }
#pragma unroll
  for (int rr = 0; rr < 4; ++rr) {
    const int tok = tok0 + rr;
    float ss = 0.f;
#pragma unroll
    for (int i = 0; i < 4; ++i) ss += v[rr][i].x * v[rr][i].x + v[rr][i].y * v[rr][i].y + v[rr][i].z * v[rr][i].z + v[rr][i].w * v[rr][i].w;
    ss = wave_sum(ss);
    const float rstd = rsqrtf(ss * (1.f / 1024.f) + 1e-6f);
#pragma unroll
    for (int i = 0; i < 4; ++i) {
      int c = lane * 4 + 256 * i;
      float y0 = v[rr][i].x * rstd * gg[i].x, y1 = v[rr][i].y * rstd * gg[i].y, y2 = v[rr][i].z * rstd * gg[i].z, y3 = v[rr][i].w * rstd * gg[i].w;
      if (MODE < 2) {
        y0 = y0 * (1.f + scl[i].x) + sh[i].x; y1 = y1 * (1.f + scl[i].y) + sh[i].y; y2 = y2 * (1.f + scl[i].z) + sh[i].z; y3 = y3 * (1.f + scl[i].w) + sh[i].w;
        *(uint2*)(p.h + (size_t)tok * 1024 + c) = make_uint2(pack2(y0, y1), pack2(y2, y3));
      } else {
        *(float4*)(p.out + (size_t)tok * 1024 + c) = make_float4(y0, y1, y2, y3);
      }
    }
  }
}

DI void gemm_mainloop(f32x16 (&acc)[2][2], const bf16_t* __restrict__ A, int lda, const bf16_t* __restrict__ Bt, int ldb, int K, char* smem) {
  const int tid = threadIdx.x, lane = tid & 63, wave = tid >> 6;
  const int wm = wave >> 1, wn = wave & 1;
  const int lr = tid >> 3, lc = tid & 7;
  const bf16_t* ap = A + (size_t)lr * lda + lc * 8;
  const bf16_t* bp = Bt + (size_t)lr * ldb + lc * 8;
  const int woff = lr * 128 + ((lc ^ (lr & 7)) << 4);
  const size_t sa = (size_t)32 * lda, sb = (size_t)32 * ldb;
  uint4 a0, a1, a2, a3, b0, b1, b2, b3;
  uint4 c0, c1, c2, c3, d0, d1, d2, d3;
#define GL0(k0) do { a0 = *(const uint4*)(ap + (k0)); a1 = *(const uint4*)(ap + sa + (k0)); a2 = *(const uint4*)(ap + 2 * sa + (k0)); a3 = *(const uint4*)(ap + 3 * sa + (k0)); \
                     b0 = *(const uint4*)(bp + (k0)); b1 = *(const uint4*)(bp + sb + (k0)); b2 = *(const uint4*)(bp + 2 * sb + (k0)); b3 = *(const uint4*)(bp + 3 * sb + (k0)); } while (0)
#define GL1(k0) do { c0 = *(const uint4*)(ap + (k0)); c1 = *(const uint4*)(ap + sa + (k0)); c2 = *(const uint4*)(ap + 2 * sa + (k0)); c3 = *(const uint4*)(ap + 3 * sa + (k0)); \
                     d0 = *(const uint4*)(bp + (k0)); d1 = *(const uint4*)(bp + sb + (k0)); d2 = *(const uint4*)(bp + 2 * sb + (k0)); d3 = *(const uint4*)(bp + 3 * sb + (k0)); } while (0)
#define SW0(buf) do { char* w_ = smem + (buf) * 32768 + woff; *(uint4*)(w_) = a0; *(uint4*)(w_ + 4096) = a1; *(uint4*)(w_ + 8192) = a2; *(uint4*)(w_ + 12288) = a3; \
                      *(uint4*)(w_ + 16384) = b0; *(uint4*)(w_ + 20480) = b1; *(uint4*)(w_ + 24576) = b2; *(uint4*)(w_ + 28672) = b3; } while (0)
#define SW1(buf) do { char* w_ = smem + (buf) * 32768 + woff; *(uint4*)(w_) = c0; *(uint4*)(w_ + 4096) = c1; *(uint4*)(w_ + 8192) = c2; *(uint4*)(w_ + 12288) = c3; \
                      *(uint4*)(w_ + 16384) = d0; *(uint4*)(w_ + 20480) = d1; *(uint4*)(w_ + 24576) = d2; *(uint4*)(w_ + 28672) = d3; } while (0)
  const int l31 = lane & 31, hh = lane >> 5, l7 = lane & 7;
  const int arow = (wm * 64 + l31) * 128, brow = 16384 + (wn * 64 + l31) * 128;
#define COMPUTE(buf) do { const char* as_ = smem + (buf) * 32768; \
    _Pragma("unroll") for (int ks = 0; ks < 4; ++ks) { \
      const int ch = ((ks * 2 + hh) ^ l7) << 4; \
      bf16x8 af0 = *(const bf16x8*)(as_ + arow + ch), af1 = *(const bf16x8*)(as_ + arow + 4096 + ch); \
      bf16x8 bf0 = *(const bf16x8*)(as_ + brow + ch), bf1 = *(const bf16x8*)(as_ + brow + 4096 + ch); \
      acc[0][0] = MFMA(af0, bf0, acc[0][0]); acc[0][1] = MFMA(af0, bf1, acc[0][1]); \
      acc[1][0] = MFMA(af1, bf0, acc[1][0]); acc[1][1] = MFMA(af1, bf1, acc[1][1]); } } while (0)
  const int nk = K >> 6;
  const int klast = (nk - 1) * 64;
  GL0(0);
  SW0(0);
  GL0(64);
  GL1(min(128, klast));
  __syncthreads();
  for (int kt = 0; kt < nk; kt += 2) {
    COMPUTE(0);
    SW0(1);
    GL0(min((kt + 3) * 64, klast));
    __syncthreads();
    COMPUTE(1);
    SW1(0);
    GL1(min((kt + 4) * 64, klast));
    __syncthreads();
  }
#undef GL0
#undef GL1
#undef SW0
#undef SW1
#undef COMPUTE
}

DI void zero_acc(f32x16 (&acc)[2][2]) {
#pragma unroll
  for (int i = 0; i < 2; ++i)
#pragma unroll
    for (int j = 0; j < 2; ++j)
#pragma unroll
      for (int r = 0; r < 16; ++r) acc[i][j][r] = 0.f;
}

template <int EPI> DI void gemm_unit(const Params& p, int u, char* smem) {
  const int mt = u & 63, nt = u >> 6;
  const int m0 = mt * 128, n0 = nt * 128;
  const int tid = threadIdx.x, lane = tid & 63, wave = tid >> 6;
  const int wm = wave >> 1, wn = wave & 1, l31 = lane & 31, hh = lane >> 5;
  f32x16 acc[2][2];
  zero_acc(acc);
  if (EPI == 0) gemm_mainloop(acc, p.h + (size_t)m0 * 1024, 1024, p.wt_in + (size_t)n0 * 1024, 1024, 1024, smem);
  if (EPI == 2) gemm_mainloop(acc, p.merged + (size_t)m0 * 1024, 1024, p.wt_out + (size_t)n0 * 1024, 1024, 1024, smem);
  if (EPI == 3) gemm_mainloop(acc, p.h + (size_t)m0 * 1024, 1024, p.wt_up + (size_t)n0 * 1024, 1024, 1024, smem);
  if (EPI == 4) gemm_mainloop(acc, p.act + (size_t)m0 * 2816, 2816, p.wt_down + (size_t)n0 * 2816, 2816, 2816, smem);
  if (EPI == 1) gemm_mainloop(acc, p.attn_o + (size_t)m0 * 512, 512, p.wt_attn + (size_t)n0 * 512, 512, 512, smem);
  if (EPI == 5) gemm_mainloop(acc, p.rwkv_o + (size_t)m0 * 512, 512, p.wt_rwkv + (size_t)n0 * 512, 512, 512, smem);
  float* et = (float*)smem;
#pragma unroll
  for (int i = 0; i < 2; ++i)
#pragma unroll
    for (int j = 0; j < 2; ++j)
#pragma unroll
      for (int r = 0; r < 16; ++r)
        et[(wm * 64 + i * 32 + (r & 3) + 8 * (r >> 2) + 4 * hh) * 132 + wn * 64 + j * 32 + l31] = acc[i][j][r];
  __syncthreads();
#pragma unroll 4
  for (int it = 0; it < 16; ++it) {
    const int id = tid + 256 * it;
    const int row = id >> 5, c4 = (id & 31) * 4;
    const float4 v = *(const float4*)(et + row * 132 + c4);
    const int m = m0 + row, n = n0 + c4;
    if (EPI == 0) {
      const uint2 o = make_uint2(pack2(v.x, v.y), pack2(v.z, v.w));
      if (n0 < 2560) *(uint2*)(p.projA + (size_t)m * 2560 + n) = o;
      else *(uint2*)(p.gates + (size_t)m * 2048 + (n - 2560)) = o;
    } else if (EPI == 1) {
      const uint2 g = *(const uint2*)(p.gates + (size_t)m * 2048 + n);
      *(uint2*)(p.merged + (size_t)m * 1024 + n) = make_uint2(pack2(v.x * sigmoidf_(bflo(g.x)), v.y * sigmoidf_(bfhi(g.x))),
                                                             pack2(v.z * sigmoidf_(bflo(g.y)), v.w * sigmoidf_(bfhi(g.y))));
    } else if (EPI == 5) {
      const uint2 g = *(const uint2*)(p.gates + (size_t)m * 2048 + 1024 + n);
      uint2* mp = (uint2*)(p.merged + (size_t)m * 1024 + n);
      const uint2 o = *mp;
      *mp = make_uint2(pack2(bflo(o.x) + v.x * sigmoidf_(bflo(g.x)), bfhi(o.x) + v.y * sigmoidf_(bfhi(g.x))),
                       pack2(bflo(o.y) + v.z * sigmoidf_(bflo(g.y)), bfhi(o.y) + v.w * sigmoidf_(bfhi(g.y))));
    } else if (EPI == 2) {
      const float4 g1 = *(const float4*)(p.mod + modrow(m) * 6144 + 2 * 1024 + n);
      const float4 x = *(const float4*)(xrow(p, m) + n);
      *(float4*)(p.out + (size_t)m * 1024 + n) = make_float4(x.x + g1.x * v.x, x.y + g1.y * v.y, x.z + g1.z * v.z, x.w + g1.w * v.w);
    } else if (EPI == 3) {
      *(uint2*)(p.up + (size_t)m * 5632 + n) = make_uint2(pack2(v.x, v.y), pack2(v.z, v.w));
    } else {
      const float4 g2 = *(const float4*)(p.mod + modrow(m) * 6144 + 5 * 1024 + n);
      float4* o = (float4*)(p.out + (size_t)m * 1024 + n);
      const float4 x = *o;
      *o = make_float4(x.x + g2.x * v.x, x.y + g2.y * v.y, x.z + g2.z * v.z, x.w + g2.w * v.w);
    }
  }
  __syncthreads();
}

#define WPITCH 80
#define WSTAGE (384 * WPITCH)
DI void gemm_mainloop_wide(f32x16 (&acc)[4][2], const bf16_t* __restrict__ A, const bf16_t* __restrict__ Bt, char* smem) {
  const int tid = threadIdx.x, lane = tid & 63, wave = tid >> 6;
  const int wm = wave >> 1, wn = wave & 1;
  const int lr = tid >> 2, lc = tid & 3;
  const bf16_t* ap = A + (size_t)lr * 1024 + lc * 8;
  const bf16_t* bp = Bt + (size_t)lr * 1024 + lc * 8;
  const int woff = lr * WPITCH + lc * 16;
  const size_t st64 = (size_t)64 * 1024;
  uint4 a0, a1, a2, a3, b0, b1;
  uint4 c0, c1, c2, c3, d0, d1;
#define WGL0(k0) do { a0 = *(const uint4*)(ap + (k0)); a1 = *(const uint4*)(ap + st64 + (k0)); a2 = *(const uint4*)(ap + 2 * st64 + (k0)); a3 = *(const uint4*)(ap + 3 * st64 + (k0)); \
                      b0 = *(const uint4*)(bp + (k0)); b1 = *(const uint4*)(bp + st64 + (k0)); } while (0)
#define WGL1(k0) do { c0 = *(const uint4*)(ap + (k0)); c1 = *(const uint4*)(ap + st64 + (k0)); c2 = *(const uint4*)(ap + 2 * st64 + (k0)); c3 = *(const uint4*)(ap + 3 * st64 + (k0)); \
                      d0 = *(const uint4*)(bp + (k0)); d1 = *(const uint4*)(bp + st64 + (k0)); } while (0)
#define WSW0(buf) do { char* w_ = smem + (buf) * WSTAGE + woff; *(uint4*)(w_) = a0; *(uint4*)(w_ + 64 * WPITCH) = a1; *(uint4*)(w_ + 128 * WPITCH) = a2; *(uint4*)(w_ + 192 * WPITCH) = a3; \
                       *(uint4*)(w_ + 256 * WPITCH) = b0; *(uint4*)(w_ + 320 * WPITCH) = b1; } while (0)
#define WSW1(buf) do { char* w_ = smem + (buf) * WSTAGE + woff; *(uint4*)(w_) = c0; *(uint4*)(w_ + 64 * WPITCH) = c1; *(uint4*)(w_ + 128 * WPITCH) = c2; *(uint4*)(w_ + 192 * WPITCH) = c3; \
                       *(uint4*)(w_ + 256 * WPITCH) = d0; *(uint4*)(w_ + 320 * WPITCH) = d1; } while (0)
  const int l31 = lane & 31, hh = lane >> 5;
  const int arow = (wm * 128 + l31) * WPITCH, brow = (256 + wn * 64 + l31) * WPITCH;
#define WCOMPUTE(buf) do { const char* as_ = smem + (buf) * WSTAGE; \
    _Pragma("unroll") for (int ks = 0; ks < 2; ++ks) { \
      const int ch = (ks * 2 + hh) * 16; \
      bf16x8 bf0 = *(const bf16x8*)(as_ + brow + ch), bf1 = *(const bf16x8*)(as_ + brow + 32 * WPITCH + ch); \
      _Pragma("unroll") for (int i = 0; i < 4; ++i) { \
        bf16x8 af = *(const bf16x8*)(as_ + arow + i * 32 * WPITCH + ch); \
        acc[i][0] = MFMA(af, bf0, acc[i][0]); acc[i][1] = MFMA(af, bf1, acc[i][1]); } } } while (0)
  const int nk = 32;
  const int klast = (nk - 1) * 32;
  WGL0(0);
  WSW0(0);
  WGL0(32);
  WGL1(64);
  __syncthreads();
  for (int kt = 0; kt < nk; kt += 2) {
    WCOMPUTE(0);
    WSW0(1);
    WGL0(min((kt + 3) * 32, klast));
    __syncthreads();
    WCOMPUTE(1);
    WSW1(0);
    WGL1(min((kt + 4) * 32, klast));
    __syncthreads();
  }
#undef WGL0
#undef WGL1
#undef WSW0
#undef WSW1
#undef WCOMPUTE
}

template <int EPI> DI void gemm_unit_wide(const Params& p, int mt, int nt, char* smem) {
  const int m0 = mt * 256, n0 = nt * 128;
  const int tid = threadIdx.x, lane = tid & 63, wave = tid >> 6;
  const int wm = wave >> 1, wn = wave & 1, l31 = lane & 31, hh = lane >> 5;
  f32x16 acc[4][2];
#pragma unroll
  for (int i = 0; i < 4; ++i)
#pragma unroll
    for (int j = 0; j < 2; ++j)
#pragma unroll
      for (int r = 0; r < 16; ++r) acc[i][j][r] = 0.f;
  gemm_mainloop_wide(acc, p.h + (size_t)m0 * 1024, (EPI == 0 ? p.wt_in : p.wt_up) + (size_t)n0 * 1024, smem);
#pragma unroll
  for (int i = 0; i < 4; ++i)
#pragma unroll
    for (int j = 0; j < 2; ++j)
#pragma unroll
      for (int r = 0; r < 16; ++r) {
        if ((r & 7) == 0) asm volatile("" ::: "memory");
        const int m = m0 + wm * 128 + i * 32 + (r & 3) + 8 * (r >> 2) + 4 * hh;
        const int n = n0 + wn * 64 + j * 32 + l31;
        const float a = acc[i][j][r];
        (void)m; (void)n; (void)a;
      }
  if (EPI == 0) {
    char* wl = smem + wave * (128 * 144);
#pragma unroll
    for (int i = 0; i < 4; ++i)
#pragma unroll
      for (int j = 0; j < 2; ++j)
#pragma unroll
        for (int r = 0; r < 16; ++r) {
          const int row = i * 32 + (r & 3) + 8 * (r >> 2) + 4 * hh;
          *(bf16_t*)(wl + row * 144 + (j * 32 + l31) * 2) = f2bf(acc[i][j][r]);
        }
    __syncthreads();
    const int rr = lane >> 3, cc = lane & 7;
    bf16_t* dst = (n0 < 2560) ? p.projA + (size_t)(m0 + wm * 128) * 2560 + n0 + wn * 64 + cc * 8
                              : p.gates + (size_t)(m0 + wm * 128) * 2048 + (n0 - 2560) + wn * 64 + cc * 8;
    const size_t ldd = (n0 < 2560) ? 2560 : 2048;
#pragma unroll
    for (int it = 0; it < 16; ++it) {
      const int row = it * 8 + rr;
      *(uint4*)(dst + (size_t)row * ldd) = *(const uint4*)(wl + row * 144 + cc * 16);
    }
    __syncthreads();
  }
  if (EPI == 3) {
    char* wl = smem + wave * 16384;
#pragma unroll
    for (int i = 0; i < 4; ++i)
#pragma unroll
      for (int r = 0; r < 16; ++r) {
        const int row = i * 32 + (r & 3) + 8 * (r >> 2) + 4 * hh;
        *(bf16_t*)(wl + row * 64 + l31 * 2) = f2bf(acc[i][0][r]);
        *(bf16_t*)(wl + 8192 + row * 64 + l31 * 2) = f2bf(acc[i][1][r]);
      }
    __syncthreads();
    const int ch = lane & 31, half = lane >> 5;
    const int chg = nt * 64 + wn * 32 + ch;
    const float wu0 = p.ffn_conv[chg], wu1 = p.ffn_conv[5632 + chg], wu2 = p.ffn_conv[2 * 5632 + chg];
    const float wg0 = p.ffn_conv[2816 + chg], wg1 = p.ffn_conv[5632 + 2816 + chg], wg2 = p.ffn_conv[2 * 5632 + 2816 + chg];
    const int blk = mt * 2 + wm;
    const int rb = half * 64;
    const char* ul = wl + ch * 2;
    const char* gl = wl + 8192 + ch * 2;
    bf16_t pu = rb ? *(const bf16_t*)(ul + (rb - 1) * 64) : (bf16_t)0, pg = rb ? *(const bf16_t*)(gl + (rb - 1) * 64) : (bf16_t)0;
    bf16_t cu = *(const bf16_t*)(ul + rb * 64), cg = *(const bf16_t*)(gl + rb * 64);
#pragma unroll 8
    for (int q = 0; q < 64; ++q) {
      const int L = rb + q;
      bf16_t nu = 0, ng = 0;
      if (L < 127) { nu = *(const bf16_t*)(ul + (L + 1) * 64); ng = *(const bf16_t*)(gl + (L + 1) * 64); }
      if (L == 0 || L == 1 || L == 126 || L == 127) {
        bf16_t* e = p.edge + ((size_t)blk * 4 + (L < 2 ? L : L - 124)) * 5632;
        e[chg] = cu; e[2816 + chg] = cg;
      }
      if (L != 0 && L != 127) {
        const float uu = bf2f(pu) * wu0 + bf2f(cu) * wu1 + bf2f(nu) * wu2;
        const float gg = bf2f(pg) * wg0 + bf2f(cg) * wg1 + bf2f(ng) * wg2;
        p.act[(size_t)(blk * 128 + L) * 2816 + chg] = f2bf(gg * sigmoidf_(gg) * uu);
      }
      pu = cu; pg = cg; cu = nu; cg = ng;
    }
    __syncthreads();
  }
}

DI void load4bf(const bf16_t* p, float (&o)[4]) {
  uint2 v = *(const uint2*)p;
  o[0] = bflo(v.x); o[1] = bfhi(v.x); o[2] = bflo(v.y); o[3] = bfhi(v.y);
}
struct APIn { uint2 qlo, qhi, klo, khi; };
DI APIn attn_prep_load(const Params& p, int tok, int lane) {
  const bf16_t* pr = p.projA + (size_t)tok * 2560;
  const int sub = lane & 7, hd = lane >> 3, kvh = (lane >> 3) & 1;
  APIn r;
  r.qlo = *(const uint2*)(pr + hd * 64 + sub * 4);
  r.qhi = *(const uint2*)(pr + hd * 64 + 32 + sub * 4);
  r.klo = *(const uint2*)(pr + 512 + kvh * 64 + sub * 4);
  r.khi = *(const uint2*)(pr + 512 + kvh * 64 + 32 + sub * 4);
  return r;
}
DI void unpk4(uint2 v, float (&o)[4]) { o[0] = bflo(v.x); o[1] = bfhi(v.x); o[2] = bflo(v.y); o[3] = bfhi(v.y); }
DI void attn_prep_token(const Params& p, int tok, int lane, const APIn& in) {
  const int sub = lane & 7;
  const bool latent = tok >= 4096;
  int s, t, L;
  if (!latent) { s = tok >> 8; t = tok & 255; L = 256; }
  else { s = (tok - 4096) >> 10; t = (tok - 4096) & 1023; L = 1024; }
  float cs[4], sn[4];
  if (latent) {
    const int row = t >> 6, col = t & 63;
#pragma unroll
    for (int i = 0; i < 4; ++i) {
      int pi = sub * 4 + i;
      float inv = __builtin_amdgcn_exp2f(-(float)(pi & 15) * 0.83048202372184059f);
      float ang = (pi < 16 ? (float)row : (float)col) * inv;
      sn[i] = __sinf(ang); cs[i] = __cosf(ang);
    }
  }
  {
    const int hd = lane >> 3;
    float lo[4], hi[4];
    unpk4(in.qlo, lo);
    unpk4(in.qhi, hi);
    float ss = 0.f;
#pragma unroll
    for (int i = 0; i < 4; ++i) ss += lo[i] * lo[i] + hi[i] * hi[i];
    ss = red8(ss);
    const float rinv = rsqrtf(ss * (1.f / 64.f) + 1e-6f);
    float4 gl = *(const float4*)(p.q_norm_g + sub * 4), gh = *(const float4*)(p.q_norm_g + 32 + sub * 4);
    const float glv[4] = {gl.x, gl.y, gl.z, gl.w}, ghv[4] = {gh.x, gh.y, gh.z, gh.w};
#pragma unroll
    for (int i = 0; i < 4; ++i) {
      float a = lo[i] * rinv * glv[i], b = hi[i] * rinv * ghv[i];
      if (latent) { float na = a * cs[i] - b * sn[i]; float nb = b * cs[i] + a * sn[i]; a = na; b = nb; }
      lo[i] = a * QSCALE; hi[i] = b * QSCALE;
    }
    size_t qo = latent ? (size_t)4096 * 512 + ((size_t)(s * 8 + hd) * 1024 + t) * 64 : ((size_t)(s * 8 + hd) * 256 + t) * 64;
    *(uint2*)(p.q + qo + sub * 4) = make_uint2(pack2(lo[0], lo[1]), pack2(lo[2], lo[3]));
    *(uint2*)(p.q + qo + 32 + sub * 4) = make_uint2(pack2(hi[0], hi[1]), pack2(hi[2], hi[3]));
  }
  {
    const int kvh = (lane >> 3) & 1;
    float lo[4], hi[4];
    unpk4(in.klo, lo);
    unpk4(in.khi, hi);
    float ss = 0.f;
#pragma unroll
    for (int i = 0; i < 4; ++i) ss += lo[i] * lo[i] + hi[i] * hi[i];
    ss = red8(ss);
    const float rinv = rsqrtf(ss * (1.f / 64.f) + 1e-6f);
    float4 gl = *(const float4*)(p.k_norm_g + sub * 4), gh = *(const float4*)(p.k_norm_g + 32 + sub * 4);
    const float glv[4] = {gl.x, gl.y, gl.z, gl.w}, ghv[4] = {gh.x, gh.y, gh.z, gh.w};
#pragma unroll
    for (int i = 0; i < 4; ++i) { lo[i] = lo[i] * rinv * glv[i]; hi[i] = hi[i] * rinv * ghv[i]; }
    if (lane < 16) {
      if (!latent) {
        float* ok = p.out + (size_t)2 * 4194304 + ((size_t)(s * 2 + kvh) * 256 + t) * 64;
        *(float4*)(ok + sub * 4) = make_float4(lo[0], lo[1], lo[2], lo[3]);
        *(float4*)(ok + 32 + sub * 4) = make_float4(hi[0], hi[1], hi[2], hi[3]);
        bf16_t* kb = p.Kc + ((size_t)(s * 2 + kvh) * 256 + t) * 64;
        *(uint2*)(kb + sub * 4) = make_uint2(pack2(lo[0], lo[1]), pack2(lo[2], lo[3]));
        *(uint2*)(kb + 32 + sub * 4) = make_uint2(pack2(hi[0], hi[1]), pack2(hi[2], hi[3]));
      } else {
#pragma unroll
        for (int i = 0; i < 4; ++i) {
          float a = lo[i], b = hi[i];
          lo[i] = a * cs[i] - b * sn[i]; hi[i] = b * cs[i] + a * sn[i];
        }
        bf16_t* kb = p.Kl + ((size_t)(s * 2 + kvh) * 1536 + t) * 64;
        *(uint2*)(kb + sub * 4) = make_uint2(pack2(lo[0], lo[1]), pack2(lo[2], lo[3]));
        *(uint2*)(kb + 32 + sub * 4) = make_uint2(pack2(hi[0], hi[1]), pack2(hi[2], hi[3]));
      }
    }
  }
  (void)L;
}

DI void attn_prep_unit(const Params& p, int u) {
  int lane = threadIdx.x & 63;
  asm volatile("" : "+v"(lane));
  const int tok0 = u * 16 + (threadIdx.x >> 6) * 4;
  APIn in[4];
#pragma unroll
  for (int i = 0; i < 4; ++i) in[i] = attn_prep_load(p, tok0 + i, lane);
#pragma unroll
  for (int i = 0; i < 4; ++i) attn_prep_token(p, tok0 + i, lane, in[i]);
}

DI void v_prep_unit(const Params& p, int u) {
  int tid = threadIdx.x;
  asm volatile("" : "+v"(tid));
  const int lane = tid & 63, wave = tid >> 6;
  const int tok0 = u * 32 + wave * 8;
  const bool latent = tok0 >= 4096;
  int s, t0, LK;
  if (!latent) { s = tok0 >> 8; t0 = tok0 & 255; LK = 256; }
  else { s = (tok0 - 4096) >> 10; t0 = (tok0 - 4096) & 1023; LK = 1536; }
#pragma unroll
  for (int kvh = 0; kvh < 2; ++kvh) {
    unsigned short raw[8];
#pragma unroll
    for (int j = 0; j < 8; ++j) raw[j] = p.projA[(size_t)(tok0 + j) * 2560 + 640 + kvh * 64 + lane];
    if (!latent) {
      float* ov = p.out + (size_t)2 * 4194304 + 524288 + ((size_t)(s * 2 + kvh) * 256 + t0) * 64 + lane;
#pragma unroll
      for (int j = 0; j < 8; ++j) ov[j * 64] = bf2f(raw[j]);
    }
    bf16_t* vt = (latent ? p.Vtl : p.Vtc) + ((size_t)(s * 2 + kvh) * 64 + lane) * LK + t0;
    *(uint4*)vt = make_uint4((unsigned)raw[0] | ((unsigned)raw[1] << 16), (unsigned)raw[2] | ((unsigned)raw[3] << 16),
                             (unsigned)raw[4] | ((unsigned)raw[5] << 16), (unsigned)raw[6] | ((unsigned)raw[7] << 16));
  }
}

DI void cache_conv_unit(const Params& p, int u, char* smem) {
  int tid = threadIdx.x;
  asm volatile("" : "+v"(tid));
  const int kb = u & 7, bk = u >> 3;
  const float* ck = p.cache_k + ((size_t)bk * 512 + kb * 64) * 64;
  const float* cv = p.cache_v + ((size_t)bk * 512 + kb * 64) * 64;
  float* t = (float*)smem;
  const int tx = tid & 15, ty = tid >> 4;
#pragma unroll
  for (int i = 0; i < 4; ++i) {
    int key = ty + 16 * i;
    float4 kv = *(const float4*)(ck + key * 64 + tx * 4);
    *(uint2*)(p.Kl + ((size_t)bk * 1536 + 1024 + kb * 64 + key) * 64 + tx * 4) = make_uint2(pack2(kv.x, kv.y), pack2(kv.z, kv.w));
    float4 v = *(const float4*)(cv + key * 64 + tx * 4);
    t[key * 65 + tx * 4 + 0] = v.x; t[key * 65 + tx * 4 + 1] = v.y; t[key * 65 + tx * 4 + 2] = v.z; t[key * 65 + tx * 4 + 3] = v.w;
  }
  __syncthreads();
  const int d = tid >> 2, kc = tid & 3;
  unsigned o[8];
#pragma unroll
  for (int j = 0; j < 8; ++j) o[j] = pack2(t[(kc * 16 + 2 * j) * 65 + d], t[(kc * 16 + 2 * j + 1) * 65 + d]);
  uint4* dst = (uint4*)(p.Vtl + ((size_t)bk * 64 + d) * 1536 + 1024 + kb * 64 + kc * 16);
  dst[0] = make_uint4(o[0], o[1], o[2], o[3]);
  dst[1] = make_uint4(o[4], o[5], o[6], o[7]);
  __syncthreads();
}

#define ACT_STRIDE 528
#define RAW_OFF (32 * ACT_STRIDE)
#define RAW_STRIDE 1552
#define SMEM_BYTES (3 * 16 * 384 * 4 + 64)
DI void ld4bf_lds(const char* p, float (&o)[4]) {
  uint2 v = *(const uint2*)p;
  o[0] = bflo(v.x); o[1] = bfhi(v.x); o[2] = bflo(v.y); o[3] = bfhi(v.y);
}
DI void conv4_lds(const char* center, int boff, const float* cw, int cwcol, float (&o)[4]) {
  float c0[4], c1[4], c2[4];
  ld4bf_lds(center - RAW_STRIDE + boff, c0);
  ld4bf_lds(center + boff, c1);
  ld4bf_lds(center + RAW_STRIDE + boff, c2);
  float4 w0 = *(const float4*)(cw + cwcol), w1 = *(const float4*)(cw + 1792 + cwcol), w2 = *(const float4*)(cw + 2 * 1792 + cwcol);
  o[0] = c0[0] * w0.x + c1[0] * w1.x + c2[0] * w2.x;
  o[1] = c0[1] * w0.y + c1[1] * w1.y + c2[1] * w2.y;
  o[2] = c0[2] * w0.z + c1[2] * w1.z + c2[2] * w2.z;
  o[3] = c0[3] * w0.w + c1[3] * w1.w + c2[3] * w2.w;
}

DI void rwkv_prep_unit(const Params& p, int u, char* smem) {
  int tid = threadIdx.x;
  asm volatile("" : "+v"(tid));
  const int lane = tid & 63, wave = tid >> 6;
  const int tile = u >> 1, hg = u & 1;
  const int tok0 = tile * 32;
  int seq_start, L;
  if (tok0 < 4096) { seq_start = tok0 & ~255; L = 256; } else { seq_start = 4096 + ((tok0 - 4096) & ~1023); L = 1024; }
  const int seq_end = seq_start + L;
  {
    uint4 rg[13];
#pragma unroll
    for (int i = 0; i < 13; ++i) {
      const int idx = tid + 256 * i;
      const int row = idx / 96, rem = idx - row * 96;
      const int arr = rem >> 5, q = rem & 31;
      const int tk = tok0 - 1 + row;
      rg[i] = make_uint4(0, 0, 0, 0);
      if (idx < 34 * 96 && tk >= seq_start && tk < seq_end)
        rg[i] = *(const uint4*)(p.projA + (size_t)tk * 2560 + 768 + arr * 512 + hg * 256 + q * 8);
    }
    const int col = tid;
    const int pc = 2304 + col;
    const float w0 = p.rwkv_conv[1536 + col], w1 = p.rwkv_conv[1792 + 1536 + col], w2 = p.rwkv_conv[2 * 1792 + 1536 + col];
    float xv[18];
#pragma unroll
    for (int i = 0; i < 18; ++i) {
      const int tk = tok0 - 1 + i;
      xv[i] = (tk >= seq_start && tk < seq_end) ? bf2f(p.projA[(size_t)tk * 2560 + pc]) : 0.f;
    }
#pragma unroll
    for (int i = 0; i < 13; ++i) {
      const int idx = tid + 256 * i;
      const int row = idx / 96, rem = idx - row * 96;
      if (idx < 34 * 96) *(uint4*)(smem + RAW_OFF + row * RAW_STRIDE + rem * 16) = rg[i];
    }
#pragma unroll 1
    for (int half = 0; half < 2; ++half) {
      float xn[18];
      if (half == 0) {
#pragma unroll
        for (int i = 0; i < 18; ++i) {
          const int tk = tok0 + 15 + i;
          xn[i] = (tk >= seq_start && tk < seq_end) ? bf2f(p.projA[(size_t)tk * 2560 + pc]) : 0.f;
        }
      }
#pragma unroll
      for (int i = 0; i < 16; ++i) {
        float v = xv[i] * w0 + xv[i + 1] * w1 + xv[i + 2] * w2;
        if (col < 64) v = 1.f - 2.f * __builtin_amdgcn_rcpf(__expf(2.f * v) + 1.f);
        else if (col >= 128) v = sigmoidf_(v);
        *(bf16_t*)(smem + (half * 16 + i) * ACT_STRIDE + col * 2) = f2bf(v);
      }
      if (half == 0) {
#pragma unroll
        for (int i = 0; i < 18; ++i) xv[i] = xn[i];
      }
    }
  }
  __syncthreads();
  const int hd = hg * 4 + wave;
  const int n = lane & 31, hh = lane >> 5;
  const int tok = tok0 + n;
  const char* actrow = smem + n * ACT_STRIDE;
  const char* center = smem + RAW_OFF + (n + 1) * RAW_STRIDE;
  const int hb = wave * 128;
  float ss = 0.f;
#pragma unroll 1
  for (int tl = 0; tl < 2; ++tl)
#pragma unroll
    for (int g = 0; g < 4; ++g) {
      int c64 = tl * 32 + 8 * g + 4 * hh;
      int ch = hd * 64 + c64;
      float kc[4];
      conv4_lds(center, 512 + hb + c64 * 2, p.rwkv_conv, 512 + ch, kc);
      float4 kkw = *(const float4*)(p.k_k + ch);
      float a0 = kc[0] * kkw.x, a1 = kc[1] * kkw.y, a2 = kc[2] * kkw.z, a3 = kc[3] * kkw.w;
      ss += a0 * a0 + a1 * a1 + a2 * a2 + a3 * a3;
    }
  ss += __shfl_xor(ss, 32);
  const float kkinv = rsqrtf(ss + 1e-12f);
  {
    f32x16 ag[2];
#pragma unroll
    for (int tl = 0; tl < 2; ++tl)
#pragma unroll
      for (int r = 0; r < 16; ++r) ag[tl][r] = 0.f;
#pragma unroll
    for (int ks = 0; ks < 8; ++ks) {
      bf16x8 bfr = *(const bf16x8*)(actrow + (128 + ks * 16 + hh * 8) * 2);
#pragma unroll
      for (int tl = 0; tl < 2; ++tl) {
        bf16x8 af = *(const bf16x8*)(p.wt_g2 + (size_t)(hd * 64 + tl * 32 + n) * 128 + ks * 16 + hh * 8);
        ag[tl] = MFMA(af, bfr, ag[tl]);
      }
    }
#pragma unroll
    for (int tl = 0; tl < 2; ++tl)
#pragma unroll
      for (int g = 0; g < 4; ++g) {
        nt_store2(p.gbuf + Gidx(tok, hd, tl * 8 + 2 * g + hh), pack2(ag[tl][4 * g], ag[tl][4 * g + 1]), pack2(ag[tl][4 * g + 2], ag[tl][4 * g + 3]));
      }
  }
  float bs0 = 0.f, bs1 = 0.f;
#pragma unroll 1
  for (int tl = 0; tl < 2; ++tl) {
    unsigned kcp[8], rp[8], kkp[8];
#pragma unroll
    for (int g = 0; g < 4; ++g) {
      asm volatile("" ::: "memory");
      int c64 = tl * 32 + 8 * g + 4 * hh;
      int ch = hd * 64 + c64;
      float r4[4], k4[4], v4[4];
      conv4_lds(center, hb + c64 * 2, p.rwkv_conv, ch, r4);
      conv4_lds(center, 512 + hb + c64 * 2, p.rwkv_conv, 512 + ch, k4);
      conv4_lds(center, 1024 + hb + c64 * 2, p.rwkv_conv, 1024 + ch, v4);
      float4 kkw = *(const float4*)(p.k_k + ch);
      const float kkwv[4] = {kkw.x, kkw.y, kkw.z, kkw.w};
      kcp[2 * g] = pack2(k4[0], k4[1]); kcp[2 * g + 1] = pack2(k4[2], k4[3]);
      rp[2 * g] = pack2(r4[0], r4[1]); rp[2 * g + 1] = pack2(r4[2], r4[3]);
      kkp[2 * g] = pack2(k4[0] * kkwv[0] * kkinv, k4[1] * kkwv[1] * kkinv);
      kkp[2 * g + 1] = pack2(k4[2] * kkwv[2] * kkinv, k4[3] * kkwv[3] * kkinv);
      const int c4g = c64 >> 2;
      nt_store2(p.SH + SHidx(tok, hd, 0, c4g), rp[2 * g], rp[2 * g + 1]);
      nt_store2(p.SH + SHidx(tok, hd, 1, c4g), pack2(v4[0], v4[1]), pack2(v4[2], v4[3]));
      nt_store2(p.SH + SHidx(tok, hd, 2, c4g), kkp[2 * g], kkp[2 * g + 1]);
    }
#pragma unroll 1
    for (int d = 0; d < 2; ++d) {
      f32x16 aw, aa;
#pragma unroll
      for (int r = 0; r < 16; ++r) { aw[r] = 0.f; aa[r] = 0.f; }
#pragma unroll
      for (int ks = 0; ks < 4; ++ks) {
        bf16x8 bw = *(const bf16x8*)(actrow + (ks * 16 + hh * 8) * 2);
        bf16x8 ba = *(const bf16x8*)(actrow + (64 + ks * 16 + hh * 8) * 2);
        bf16x8 fw = *(const bf16x8*)(p.wt_w2 + (size_t)(d * 512 + hd * 64 + tl * 32 + n) * 64 + ks * 16 + hh * 8);
        bf16x8 fa = *(const bf16x8*)(p.wt_a2 + (size_t)(d * 512 + hd * 64 + tl * 32 + n) * 64 + ks * 16 + hh * 8);
        aw = MFMA(fw, bw, aw);
        aa = MFMA(fa, ba, aa);
      }
      float bsum = 0.f;
#pragma unroll
      for (int g = 0; g < 4; ++g) {
        asm volatile("" ::: "memory");
        int c64 = tl * 32 + 8 * g + 4 * hh;
        int ch = hd * 64 + c64;
        float4 w0v = *(const float4*)(p.w0 + d * 512 + ch);
        float4 a0v = *(const float4*)(p.a0 + d * 512 + ch);
        float4 kav = *(const float4*)(p.k_a + ch);
        float4 rkv = *(const float4*)(p.r_k + ch);
        const float w0a[4] = {w0v.x, w0v.y, w0v.z, w0v.w}, a0a[4] = {a0v.x, a0v.y, a0v.z, a0v.w};
        const float kaa[4] = {kav.x, kav.y, kav.z, kav.w}, rka[4] = {rkv.x, rkv.y, rkv.z, rkv.w};
        float wv[4], kdv[4], bv[4];
#pragma unroll
        for (int i = 0; i < 4; ++i) {
          int r = 4 * g + i;
          wv[i] = __expf(-0.60653065971263342f * sigmoidf_(w0a[i] + aw[r]));
          float a = sigmoidf_(a0a[i] + aa[r]);
          const unsigned kkw_ = kkp[2 * g + (i >> 1)], rw_ = rp[2 * g + (i >> 1)], kcw_ = kcp[2 * g + (i >> 1)];
          kdv[i] = ((i & 1) ? bfhi(kcw_) : bflo(kcw_)) * (1.f + (a - 1.f) * kaa[i]);
          bv[i] = ((i & 1) ? bfhi(kkw_) : bflo(kkw_)) * a;
          bsum += ((i & 1) ? bfhi(rw_) : bflo(rw_)) * kdv[i] * rka[i];
        }
        const int c4g = c64 >> 2;
        nt_store4f(p.DW + DWidx(d, tok, hd, c4g), wv[0], wv[1], wv[2], wv[3]);
        nt_store2(p.DK + DKidx(d, tok, hd, 0, c4g), pack2(kdv[0], kdv[1]), pack2(kdv[2], kdv[3]));
        nt_store2(p.DK + DKidx(d, tok, hd, 1, c4g), pack2(bv[0], bv[1]), pack2(bv[2], bv[3]));
      }
      if (d == 0) bs0 += bsum; else bs1 += bsum;
    }
  }
  bs0 += __shfl_xor(bs0, 32);
  bs1 += __shfl_xor(bs1, 32);
  if (hh == 0) *(float2*)(p.BS + BSidx(tok, hd)) = make_float2(bs0, bs1);
  __syncthreads();
}

#define SCH 16
#define SBUF (SCH * 384)
DI void ld8(const float* p, f32x2 (&o)[4]) {
  float4 t0 = *(const float4*)p, t1 = *(const float4*)(p + 4);
  o[0] = f32x2{t0.x, t0.y}; o[1] = f32x2{t0.z, t0.w}; o[2] = f32x2{t1.x, t1.y}; o[3] = f32x2{t1.z, t1.w};
}
DI float dot8(const f32x2 (&a)[4], const f32x2 (&b)[4]) {
  f32x2 p = a[0] * b[0] + a[1] * b[1];
  f32x2 q = a[2] * b[2] + a[3] * b[3];
  p = p + q;
  return p.x + p.y;
}
DI void scan_unit(const Params& p, int tok0, int L, int hd, int d, int rh, const float* s0, float* sout, char* smem) {
  const int tid = threadIdx.x;
  const int row = rh * 32 + (tid >> 3), seg = tid & 7;
  f32x2 S[4];
  if (s0) {
    ld8(s0 + row * 64 + seg * 8, S);
  } else {
#pragma unroll
    for (int j = 0; j < 4; ++j) S[j] = f32x2{0.f, 0.f};
  }
  float* buf = (float*)smem;
  const int nchunk = L / SCH;
  struct Stg { uint2 a[2], b[2], k[2]; uint4 w[2]; };
  Stg G0, G1;
#pragma unroll
  for (int q = 0; q < 2; ++q) { G0.a[q] = G0.b[q] = G0.k[q] = make_uint2(0, 0); G0.w[q] = make_uint4(0, 0, 0, 0); }
  G1 = G0;
  const int s_jt = tid & 7, s_g = (tid >> 3) & 15, s_hi = tid >> 7;
  auto gload = [&](int c, Stg& r) {
#pragma unroll
    for (int q = 0; q < 2; ++q) {
      const int tk = tok0 + (d == 0 ? c * SCH : L - SCH - c * SCH) + s_jt + 8 * q;
      r.a[q] = *(const uint2*)(p.SH + SHidx(tk, hd, s_hi, s_g));
      r.k[q] = *(const uint2*)(p.DK + DKidx(d, tk, hd, s_hi, s_g));
      if (s_hi == 0) r.b[q] = *(const uint2*)(p.SH + SHidx(tk, hd, 2, s_g));
      else r.w[q] = *(const uint4*)(p.DW + DWidx(d, tk, hd, s_g));
    }
  };
  auto put4 = [&](float* dst, uint2 v) { *(float4*)dst = make_float4(bflo(v.x), bfhi(v.x), bflo(v.y), bfhi(v.y)); };
  auto swrite = [&](int b, const Stg& r) {
#pragma unroll
    for (int q = 0; q < 2; ++q) {
      const int jt = s_jt + 8 * q;
      float* bb = buf + b * SBUF + ((d == 0) ? jt : SCH - 1 - jt) * 384 + s_g * 4;
      put4(bb + (s_hi == 0 ? 4 : 5) * 64, r.a[q]);
      put4(bb + (s_hi == 0 ? 3 : 2) * 64, r.k[q]);
      if (s_hi == 0) put4(bb, r.b[q]);
      else *(uint4*)(bb + 64) = r.w[q];
    }
  };
  gload(0, G0);
  gload(1, G1);
  swrite(0, G0);
  swrite(1, G1);
  if (2 < nchunk) gload(2, G0);
  __syncthreads();
  float sa;
  {
    f32x2 k0[4];
    ld8(buf + seg * 8, k0);
    sa = -red8(dot8(S, k0));
  }
  float ykeep = 0.f, ykeep2 = 0.f;
  int b0 = 0, b1 = 1, b2 = 2;
  auto chunk_body = [&](int c, Stg& iS, const Stg& wS) {
    const bool more2 = (c + 2 < nchunk);
    if (c + 3 < nchunk) gload(c + 3, iS);
    const float* cb = buf + b0 * SBUF + seg * 8;
    const float* nbp = (c + 1 < nchunk) ? buf + b1 * SBUF + seg * 8 : cb + (SCH - 1) * 384;
    const float* vrow = buf + b0 * SBUF + 320 + row;
    f32x2 w[4], bb[4], kd[4], r[4], kn[4];
    float vv;
    ld8(cb + 64, w); ld8(cb + 192, kd); ld8(cb + 384, kn); ld8(cb + 128, bb); ld8(cb + 256, r);
    vv = vrow[0];
#pragma unroll
    for (int i = 0; i < SCH; ++i) {
      asm volatile("" ::: "memory");
      f32x2 nw[4], nbb[4], nkd[4], nr[4], nkn[4];
      float nvv = 0.f;
      if (i < SCH - 1) {
        const float* st = cb + (i + 1) * 384;
        ld8(st + 64, nw); ld8(st + 192, nkd);
        ld8((i + 1 < SCH - 1) ? st + 384 : nbp, nkn);
        ld8(st + 128, nbb); ld8(st + 256, nr);
        nvv = vrow[(i + 1) * 384];
      }
      const f32x2 vv2 = {vv, vv};
      f32x2 U[4];
#pragma unroll
      for (int j = 0; j < 4; ++j) U[j] = S[j] * w[j] + vv2 * kd[j];
      const float Ap = dot8(U, kn), Bp = dot8(bb, kn);
      const f32x2 sa2 = {sa, sa};
#pragma unroll
      for (int j = 0; j < 4; ++j) S[j] = U[j] + sa2 * bb[j];
      const float yv = red8(dot8(S, r));
      sa = -red8(Ap + sa * Bp);
      if (seg == (i & 7)) { if (i < 8) ykeep = yv; else ykeep2 = yv; }
      if (i < SCH - 1) {
#pragma unroll
        for (int j = 0; j < 4; ++j) { w[j] = nw[j]; bb[j] = nbb[j]; kd[j] = nkd[j]; r[j] = nr[j]; kn[j] = nkn[j]; }
        vv = nvv;
      }
    }
#pragma unroll
    for (int q = 0; q < 2; ++q) {
      const int ii = c * SCH + seg + 8 * q;
      const int tt = (d == 0) ? ii : (L - 1 - ii);
      p.Y[((size_t)d * NTOK + tok0 + tt) * 512 + hd * 64 + row] = q ? ykeep2 : ykeep;
    }
    if (more2) swrite(b2, wS);
    __syncthreads();
    const int t_ = b0; b0 = b1; b1 = b2; b2 = t_;
  };
#pragma unroll 1
  for (int c = 0; c < nchunk; c += 2) {
    chunk_body(c + 0, G1, G0);
    chunk_body(c + 1, G0, G1);
  }
  if (sout) {
    *(float4*)(sout + row * 64 + seg * 8) = make_float4(S[0].x, S[0].y, S[1].x, S[1].y);
    *(float4*)(sout + row * 64 + seg * 8 + 4) = make_float4(S[2].x, S[2].y, S[3].x, S[3].y);
  }
}

#define KV_STRIDE 144
DI void attn_unit(const bf16_t* __restrict__ Q, const bf16_t* __restrict__ Kb, const bf16_t* __restrict__ Vt, int LK, bf16_t* __restrict__ O, char* smem) {
  const int tid = threadIdx.x, lane = tid & 63, wave = tid >> 6;
  const int n = lane & 31, hh = lane >> 5;
  char* Ks = smem;
  char* Vs = smem + 64 * KV_STRIDE;
  bf16x8 qf[4];
#pragma unroll
  for (int ks = 0; ks < 4; ++ks) qf[ks] = *(const bf16x8*)(Q + (size_t)(wave * 32 + n) * 64 + ks * 16 + hh * 8);
  f32x16 ot[2];
#pragma unroll
  for (int dt = 0; dt < 2; ++dt)
#pragma unroll
    for (int r = 0; r < 16; ++r) ot[dt][r] = 0.f;
  float mrun = -1e30f, lrun = 0.f;
  const int ntile = LK >> 6;
  const int lrow = tid >> 3, lc = tid & 7;
  uint4 rk0, rk1, rv0, rv1;
  rk0 = *(const uint4*)(Kb + (size_t)(lrow) * 64 + lc * 8);
  rk1 = *(const uint4*)(Kb + (size_t)(lrow + 32) * 64 + lc * 8);
  rv0 = *(const uint4*)(Vt + (size_t)(lrow) * LK + lc * 8);
  rv1 = *(const uint4*)(Vt + (size_t)(lrow + 32) * LK + lc * 8);
  for (int kt = 0; kt < ntile; ++kt) {
    *(uint4*)(Ks + (lrow) * KV_STRIDE + lc * 16) = rk0;
    *(uint4*)(Ks + (lrow + 32) * KV_STRIDE + lc * 16) = rk1;
    *(uint4*)(Vs + (lrow) * KV_STRIDE + lc * 16) = rv0;
    *(uint4*)(Vs + (lrow + 32) * KV_STRIDE + lc * 16) = rv1;
    __syncthreads();
    if (kt + 1 < ntile) {
      rk0 = *(const uint4*)(Kb + (size_t)((kt + 1) * 64 + lrow) * 64 + lc * 8);
      rk1 = *(const uint4*)(Kb + (size_t)((kt + 1) * 64 + lrow + 32) * 64 + lc * 8);
      rv0 = *(const uint4*)(Vt + (size_t)(lrow) * LK + (kt + 1) * 64 + lc * 8);
      rv1 = *(const uint4*)(Vt + (size_t)(lrow + 32) * LK + (kt + 1) * 64 + lc * 8);
    }
    f32x16 st[2];
#pragma unroll
    for (int kb = 0; kb < 2; ++kb) {
#pragma unroll
      for (int r = 0; r < 16; ++r) st[kb][r] = 0.f;
#pragma unroll
      for (int ks = 0; ks < 4; ++ks) {
        bf16x8 af = *(const bf16x8*)(Ks + (kb * 32 + n) * KV_STRIDE + (ks * 2 + hh) * 16);
        st[kb] = MFMA(af, qf[ks], st[kb]);
      }
    }
    float mx = st[0][0];
#pragma unroll
    for (int kb = 0; kb < 2; ++kb)
#pragma unroll
      for (int r = 0; r < 16; ++r) mx = fmaxf(mx, st[kb][r]);
    mx = fmaxf(mx, __shfl_xor(mx, 32));
    const float mnew = fmaxf(mrun, mx);
    const float alpha = __builtin_amdgcn_exp2f(mrun - mnew);
    mrun = mnew;
    float ps = 0.f;
#pragma unroll
    for (int kb = 0; kb < 2; ++kb)
#pragma unroll
      for (int r = 0; r < 16; ++r) { float e = __builtin_amdgcn_exp2f(st[kb][r] - mnew); st[kb][r] = e; ps += e; }
    lrun = lrun * alpha + ps;
#pragma unroll
    for (int dt = 0; dt < 2; ++dt)
#pragma unroll
      for (int r = 0; r < 16; ++r) ot[dt][r] *= alpha;
#pragma unroll
    for (int kb = 0; kb < 2; ++kb)
#pragma unroll
      for (int s = 0; s < 2; ++s) {
        uint4 pk = make_uint4(pack2(st[kb][8 * s + 0], st[kb][8 * s + 1]), pack2(st[kb][8 * s + 2], st[kb][8 * s + 3]),
                              pack2(st[kb][8 * s + 4], st[kb][8 * s + 5]), pack2(st[kb][8 * s + 6], st[kb][8 * s + 7]));
        bf16x8 pf = __builtin_bit_cast(bf16x8, pk);
#pragma unroll
        for (int dt = 0; dt < 2; ++dt) {
          const char* vp = Vs + (dt * 32 + n) * KV_STRIDE + (kb * 32 + 16 * s + 4 * hh) * 2;
          uint2 lo = *(const uint2*)(vp), hi = *(const uint2*)(vp + 16);
          bf16x8 vf = __builtin_bit_cast(bf16x8, make_uint4(lo.x, lo.y, hi.x, hi.y));
          ot[dt] = MFMA(vf, pf, ot[dt]);
        }
      }
    __syncthreads();
  }
  lrun += __shfl_xor(lrun, 32);
  const float inv = 1.f / lrun;
#pragma unroll
  for (int dt = 0; dt < 2; ++dt)
#pragma unroll
    for (int g = 0; g < 4; ++g) {
      int dd = dt * 32 + 8 * g + 4 * hh;
      *(uint2*)(O + (size_t)(wave * 32 + n) * 512 + dd) =
          make_uint2(pack2(ot[dt][4 * g] * inv, ot[dt][4 * g + 1] * inv), pack2(ot[dt][4 * g + 2] * inv, ot[dt][4 * g + 3] * inv));
    }
}

DI void phase4(const Params& p, int u, char* smem) {
  if (u < 128) {
    const int scan = u >> 1, rh = u & 1;
    const int b = scan >> 4, hd = (scan >> 1) & 7, d = scan & 1;
    scan_unit(p, 4096 + b * 1024, 1024, hd, d, rh, p.state + ((size_t)(b * 2 + d) * 8 + hd) * 4096, nullptr, smem);
  } else if (u < 256) {
#pragma unroll 1
    for (int j = 0; j < 4; ++j) {
      const int cu = (u - 128) * 4 + j;
      const int scan = cu >> 1, rh = cu & 1;
      const int s = scan >> 4, hd = (scan >> 1) & 7, d = scan & 1;
      scan_unit(p, s * 256, 256, hd, d, rh, nullptr, p.out + (size_t)2 * 4194304 + 2 * 524288 + ((size_t)(s * 2 + d) * 8 + hd) * 4096, smem);
    }
  } else {
    const int a = u - 256;
    {
      const int qb = a & 7, hd = (a >> 3) & 7, b = a >> 6;
      const int kvh = hd >> 2;
      attn_unit(p.q + (size_t)4096 * 512 + ((size_t)(b * 8 + hd) * 1024 + qb * 128) * 64, p.Kl + (size_t)(b * 2 + kvh) * 1536 * 64,
                p.Vtl + (size_t)(b * 2 + kvh) * 64 * 1536, 1536, p.attn_o + (size_t)(4096 + b * 1024 + qb * 128) * 512 + hd * 64, smem);
    }
    {
      const int qb = a & 1, hd = (a >> 1) & 7, s = a >> 4;
      const int kvh = hd >> 2;
      attn_unit(p.q + ((size_t)(s * 8 + hd) * 256 + qb * 128) * 64, p.Kc + (size_t)(s * 2 + kvh) * 256 * 64,
                p.Vtc + (size_t)(s * 2 + kvh) * 64 * 256, 256, p.attn_o + (size_t)(s * 256 + qb * 128) * 512 + hd * 64, smem);
    }
  }
}

DI void rwkv_final_tok4(const Params& p, int tok0) {
  const int lane = threadIdx.x & 63;
  const int hd = lane >> 3, sub = lane & 7;
  const int ch = hd * 64 + sub * 8;
  float4 ya[4][2], yb[4][2];
#pragma unroll
  for (int t = 0; t < 4; ++t) {
    const float* y0 = p.Y + (size_t)(tok0 + t) * 512 + ch;
    const float* y1 = p.Y + ((size_t)NTOK + tok0 + t) * 512 + ch;
    ya[t][0] = *(const float4*)y0; ya[t][1] = *(const float4*)(y0 + 4);
    yb[t][0] = *(const float4*)y1; yb[t][1] = *(const float4*)(y1 + 4);
  }
  uint4 vr[2][2], gr[2][2];
#pragma unroll
  for (int c = 0; c < 2; ++c) {
    const uint4* vp = (const uint4*)(p.SH + SHidx(tok0, hd, 1, sub * 2 + c));
    const uint4* gp = (const uint4*)(p.gbuf + Gidx(tok0, hd, sub * 2 + c));
    vr[c][0] = vp[0]; vr[c][1] = vp[1];
    gr[c][0] = gp[0]; gr[c][1] = gp[1];
  }
  float2 bsv[4];
#pragma unroll
  for (int t = 0; t < 4; ++t) bsv[t] = *(const float2*)(p.BS + BSidx(tok0 + t, hd));
  float4 lg0 = *(const float4*)(p.ln_g + ch), lg1 = *(const float4*)(p.ln_g + ch + 4);
  float4 lb0 = *(const float4*)(p.ln_b + ch), lb1 = *(const float4*)(p.ln_b + ch + 4);
  const float lg[8] = {lg0.x, lg0.y, lg0.z, lg0.w, lg1.x, lg1.y, lg1.z, lg1.w};
  const float lb[8] = {lb0.x, lb0.y, lb0.z, lb0.w, lb1.x, lb1.y, lb1.z, lb1.w};
#pragma unroll
  for (int t = 0; t < 4; ++t) {
    float y[8] = {ya[t][0].x + yb[t][0].x, ya[t][0].y + yb[t][0].y, ya[t][0].z + yb[t][0].z, ya[t][0].w + yb[t][0].w,
                  ya[t][1].x + yb[t][1].x, ya[t][1].y + yb[t][1].y, ya[t][1].z + yb[t][1].z, ya[t][1].w + yb[t][1].w};
    float s = 0.f;
#pragma unroll
    for (int j = 0; j < 8; ++j) s += y[j];
    const float mu = red8(s) * (1.f / 64.f);
    float vs = 0.f;
#pragma unroll
    for (int j = 0; j < 8; ++j) { y[j] -= mu; vs += y[j] * y[j]; }
    const float rstd = rsqrtf(red8(vs) * (1.f / 64.f) + 64e-5f);
    const float bsum = bsv[t].x + bsv[t].y;
    unsigned vw[4], gw[4];
#pragma unroll
    for (int c = 0; c < 2; ++c) {
      const uint4 vq = vr[c][t >> 1], gq = gr[c][t >> 1];
      vw[2 * c] = (t & 1) ? vq.z : vq.x; vw[2 * c + 1] = (t & 1) ? vq.w : vq.y;
      gw[2 * c] = (t & 1) ? gq.z : gq.x; gw[2 * c + 1] = (t & 1) ? gq.w : gq.y;
    }
    const float vv[8] = {bflo(vw[0]), bfhi(vw[0]), bflo(vw[1]), bfhi(vw[1]), bflo(vw[2]), bfhi(vw[2]), bflo(vw[3]), bfhi(vw[3])};
    const float gg[8] = {bflo(gw[0]), bfhi(gw[0]), bflo(gw[1]), bfhi(gw[1]), bflo(gw[2]), bfhi(gw[2]), bflo(gw[3]), bfhi(gw[3])};
    float o[8];
#pragma unroll
    for (int j = 0; j < 8; ++j) o[j] = (y[j] * rstd * lg[j] + lb[j] + bsum * vv[j]) * gg[j];
    *(uint4*)(p.rwkv_o + (size_t)(tok0 + t) * 512 + ch) = make_uint4(pack2(o[0], o[1]), pack2(o[2], o[3]), pack2(o[4], o[5]), pack2(o[6], o[7]));
  }
}

DI void unpack8(uint4 v, float (&o)[8]) {
  o[0] = bflo(v.x); o[1] = bfhi(v.x); o[2] = bflo(v.y); o[3] = bfhi(v.y); o[4] = bflo(v.z); o[5] = bfhi(v.z); o[6] = bflo(v.w); o[7] = bfhi(v.w);
}
DI void ffn_act_unit(const Params& p, int u) {
  const int item = u * 256 + threadIdx.x;
  const int er = item / 2816, chn = item - er * 2816;
  const int blk = er >> 1, last = er & 1;
  const bool firstblk = blk < 32 ? ((blk & 1) == 0) : (((blk - 32) & 7) == 0);
  const bool lastblk = blk < 32 ? ((blk & 1) == 1) : (((blk - 32) & 7) == 7);
  const bf16_t* e = p.edge + (size_t)blk * 4 * 5632;
  float pu = 0.f, pg = 0.f, cu, cg, nu = 0.f, ng = 0.f;
  if (!last) {
    if (!firstblk) { pu = bf2f(e[-5632 + chn]); pg = bf2f(e[-5632 + 2816 + chn]); }
    cu = bf2f(e[chn]); cg = bf2f(e[2816 + chn]);
    nu = bf2f(e[5632 + chn]); ng = bf2f(e[5632 + 2816 + chn]);
  } else {
    pu = bf2f(e[2 * 5632 + chn]); pg = bf2f(e[2 * 5632 + 2816 + chn]);
    cu = bf2f(e[3 * 5632 + chn]); cg = bf2f(e[3 * 5632 + 2816 + chn]);
    if (!lastblk) { nu = bf2f(e[4 * 5632 + chn]); ng = bf2f(e[4 * 5632 + 2816 + chn]); }
  }
  const float uu = pu * p.ffn_conv[chn] + cu * p.ffn_conv[5632 + chn] + nu * p.ffn_conv[2 * 5632 + chn];
  const float gg = pg * p.ffn_conv[2816 + chn] + cg * p.ffn_conv[5632 + 2816 + chn] + ng * p.ffn_conv[2 * 5632 + 2816 + chn];
  p.act[(size_t)(blk * 128 + (last ? 127 : 0)) * 2816 + chn] = f2bf(gg * sigmoidf_(gg) * uu);
}

#define NPHASE 13
template <int PH> DI void run_phase(const Params& p, char* smem) {
  const int nb = gridDim.x;
  if (PH == 0) for (int u = blockIdx.x; u < P0_MOD_UNITS; u += nb) phase0(p, u, smem);
  if (PH == 1) for (int u = blockIdx.x; u < 512 + (P0_UNITS - P0_MOD_UNITS); u += nb) {
    if (u < 512) norm_rows<0>(p, u);
    else phase0(p, u - 512 + P0_MOD_UNITS, smem);
  }
  if (PH == 2) for (int u = blockIdx.x; u < 32 * 32 + 64 * 4; u += nb) {
    if (u < 1024) gemm_unit_wide<0>(p, u & 31, u >> 5, smem);
    else gemm_unit<0>(p, (u - 1024) + 64 * 32, smem);
  }
  if (PH == 3) for (int u = blockIdx.x; u < 512 + 512 + 64 + 256; u += nb) {
    if (u < 512) rwkv_prep_unit(p, u, smem);
    else if (u < 1024) attn_prep_unit(p, u - 512);
    else if (u < 1024 + 64) cache_conv_unit(p, u - 1024, smem);
    else v_prep_unit(p, u - 1088);
  }
  if (PH == 4) for (int u = blockIdx.x; u < 512; u += nb) phase4(p, u, smem);
  if (PH == 5) for (int u = blockIdx.x; u < 512; u += nb) rwkv_final_tok4(p, u * 16 + (threadIdx.x >> 6) * 4);
  if (PH == 6) {
#pragma unroll 1
    for (int u = blockIdx.x; u < 64 * 8; u += nb) gemm_unit<1>(p, u, smem);
    asm volatile("" ::: "memory");
#pragma unroll 1
    for (int u = blockIdx.x; u < 64 * 8; u += nb) gemm_unit<5>(p, u, smem);
  }
  if (PH == 7) for (int u = blockIdx.x; u < 64 * 8; u += nb) gemm_unit<2>(p, u, smem);
  if (PH == 8) for (int u = blockIdx.x; u < 512; u += nb) norm_rows<1>(p, u);
  if (PH == 9) for (int u = blockIdx.x; u < 32 * 44; u += nb) gemm_unit_wide<3>(p, u & 31, u >> 5, smem);
  if (PH == 10) for (int u = blockIdx.x; u < 1408; u += nb) ffn_act_unit(p, u);
  if (PH == 11) for (int u = blockIdx.x; u < 64 * 8; u += nb) gemm_unit<4>(p, u, smem);
  if (PH == 12) for (int u = blockIdx.x; u < 512; u += nb) norm_rows<2>(p, u);
}


#define XB_TMO      128
#define XB_XCNT(j)  (256  + 64 * (j))
#define XB_XSUB(j)  (1280 + 64 * (j))
#define XB_XGEN(j)  (2304 + 64 * (j))
#define XB_TOP      3328
#define XB_TOPGEN   3392
#define XCD_BAR_WORDS 3456
#define XB_SPIN_CAP (1u << 18)
#define LAS __attribute__((address_space(3)))

__device__ __forceinline__ unsigned xb_ld(unsigned* p)              { return __hip_atomic_load(p, __ATOMIC_RELAXED, __HIP_MEMORY_SCOPE_AGENT); }
__device__ __forceinline__ unsigned xb_add(unsigned* p, unsigned v) { return __hip_atomic_fetch_add(p, v, __ATOMIC_RELAXED, __HIP_MEMORY_SCOPE_AGENT); }
__device__ __forceinline__ unsigned xb_xcc_id() { return (unsigned)__builtin_amdgcn_s_getreg((3 << 11) | 20) & 0xFu; }
#define XB_SPIN(cond, bar) do { unsigned _sp = 0; while (cond) { __builtin_amdgcn_s_sleep(1); \
    if ((++_sp & 255u) == 0u) { if (xb_ld(&(bar)[XB_TMO])) break; if (_sp > XB_SPIN_CAP) { atomicAdd(&(bar)[XB_TMO], 1u); break; } } } } while (0)

struct XcdBarrier {
    unsigned* bar; unsigned x;
    volatile LAS unsigned* st;
};

__device__ __forceinline__ XcdBarrier xcd_barrier_post(unsigned* bar, volatile LAS unsigned* st) {
    XcdBarrier b; b.bar = bar; b.x = xb_xcc_id(); b.st = st;
    if (threadIdx.x == 0) (void)xb_add(&bar[XB_XCNT(b.x)], 1u);
    return b;
}
__device__ __forceinline__ void xcd_barrier_complete(unsigned* bar, unsigned x, unsigned& nloc, unsigned& nx) {
    const unsigned G = gridDim.x * gridDim.y * gridDim.z;
    unsigned sum, cnt, mine, sp = 0u;
    for (;;) {
        sum = 0u; cnt = 0u; mine = 0u;
#pragma unroll
        for (unsigned j = 0; j < 16; ++j) { const unsigned c = xb_ld(&bar[XB_XCNT(j)]); sum += c; cnt += (c > 0u) ? 1u : 0u; mine = (j == x) ? c : mine; }
        if (sum == G) break;
        __builtin_amdgcn_s_sleep(1);
        if ((++sp & 255u) == 0u) { if (xb_ld(&bar[XB_TMO])) break; if (sp > XB_SPIN_CAP) { atomicAdd(&bar[XB_TMO], 1u); break; } }
    }
    nloc = mine > 0u ? mine : 1u; nx = cnt > 0u ? cnt : 1u;
}

__device__ __forceinline__ void xcd_barrier(const XcdBarrier& b) {
    asm volatile("s_waitcnt vmcnt(0)" ::: "memory");
    __syncthreads();
    if (threadIdx.x == 0) {
        unsigned* bar = b.bar;
        __builtin_amdgcn_s_waitcnt(0);
        unsigned nloc = b.st[0], nx = b.st[1];
        if (nloc == 0u) { xcd_barrier_complete(bar, b.x, nloc, nx); b.st[0] = nloc; b.st[1] = nx; }
        const unsigned old = xb_add(&bar[XB_XSUB(b.x)], 1u);
        const unsigned gen = old / nloc;
        if (old + 1u == (gen + 1u) * nloc) {
            __builtin_amdgcn_fence(__ATOMIC_RELEASE, "agent");
            asm volatile("s_waitcnt vmcnt(0)" ::: "memory");
            const unsigned og = xb_add(&bar[XB_TOP], 1u);
            const unsigned tg = og / nx;
            if (og + 1u == (tg + 1u) * nx) xb_add(&bar[XB_TOPGEN], 1u);
            else XB_SPIN(xb_ld(&bar[XB_TOPGEN]) == tg, bar);
            __builtin_amdgcn_fence(__ATOMIC_ACQUIRE, "agent");
            xb_add(&bar[XB_XGEN(b.x)], 1u);
            asm volatile("s_waitcnt vmcnt(0)" ::: "memory");
        } else {
            XB_SPIN(xb_ld(&bar[XB_XGEN(b.x)]) == gen, bar);
            __builtin_amdgcn_fence(__ATOMIC_ACQUIRE, "agent");
            asm volatile("s_waitcnt vmcnt(0)" ::: "memory");
        }
    }
    __syncthreads();
}

#if FUSED
__global__ void __launch_bounds__(256, 2) fwd_megakernel(Params p) {
  __shared__ __attribute__((aligned(16))) char smem[SMEM_BYTES];
  cg::grid_group grid = cg::this_grid();
  if (p.never) grid.sync();
  __shared__ uint4 xb_words;
  if (threadIdx.x == 0) xb_words = make_uint4(0u, 0u, 0u, 0u);
  __syncthreads();
  {
    unsigned* bar = p.bar;
    if (blockIdx.x == 0) {
      for (int i = threadIdx.x; i < XCD_BAR_WORDS; i += 256) __hip_atomic_store(&bar[i], 0u, __ATOMIC_RELAXED, __HIP_MEMORY_SCOPE_AGENT);
      asm volatile("s_waitcnt vmcnt(0)" ::: "memory");
      __syncthreads();
      if (threadIdx.x == 0) {
        __builtin_amdgcn_fence(__ATOMIC_RELEASE, "agent");
        asm volatile("s_waitcnt vmcnt(0)" ::: "memory");
        __hip_atomic_store(&bar[BAR_READY], 0x13572468u, __ATOMIC_RELAXED, __HIP_MEMORY_SCOPE_AGENT);
      }
    }
    if (threadIdx.x == 0) {
      while (__hip_atomic_load(&bar[BAR_READY], __ATOMIC_RELAXED, __HIP_MEMORY_SCOPE_AGENT) != 0x13572468u) __builtin_amdgcn_s_sleep(1);
      __builtin_amdgcn_fence(__ATOMIC_ACQUIRE, "agent");
      asm volatile("s_waitcnt vmcnt(0)" ::: "memory");
    }
    __syncthreads();
  }
  XcdBarrier xb = xcd_barrier_post(p.bar, (volatile LAS unsigned*)&xb_words);
#define GB() xcd_barrier(xb)
  run_phase<0>(p, smem); GB();
  if (blockIdx.x == 0 && threadIdx.x == 0) __hip_atomic_store(&p.bar[BAR_READY], 0u, __ATOMIC_RELAXED, __HIP_MEMORY_SCOPE_AGENT);
  run_phase<1>(p, smem); GB();
  run_phase<2>(p, smem); GB();
  run_phase<3>(p, smem); GB();
  run_phase<4>(p, smem); GB();
  run_phase<5>(p, smem); GB();
  run_phase<6>(p, smem); GB();
  run_phase<7>(p, smem); GB();
  run_phase<8>(p, smem); GB();
  run_phase<9>(p, smem); GB();
  run_phase<10>(p, smem); GB();
  run_phase<11>(p, smem); GB();
  run_phase<12>(p, smem);
}
#else
template <int PH> __global__ void __launch_bounds__(256, 2) phase_kernel(Params p) {
  __shared__ __attribute__((aligned(16))) char smem[SMEM_BYTES];
  run_phase<PH>(p, smem);
}
#endif

extern "C" void kernel_launch(void* const* d_in, const int* in_sizes, int n_in, void* d_out, int out_size, void* d_ws,
                              size_t ws_size, hipStream_t stream) {
  Params p{};
  const float** fp = (const float**)&p;
  for (int i = 0; i < 32; ++i) fp[i] = (const float*)d_in[i];
  p.out = (float*)d_out;
  char* w = (char*)d_ws;
  size_t off = 0;
  auto take = [&](size_t bytes) { char* r = w + off; off += (bytes + 255) & ~(size_t)255; return r; };
  p.mod = (float*)take(5 * 6144 * 4);
  p.wt_in = (bf16_t*)take((size_t)4608 * 1024 * 2);
  p.wt_attn = (bf16_t*)take((size_t)1024 * 512 * 2);
  p.wt_rwkv = (bf16_t*)take((size_t)1024 * 512 * 2);
  p.wt_out = (bf16_t*)take((size_t)1024 * 1024 * 2);
  p.wt_up = (bf16_t*)take((size_t)5632 * 1024 * 2);
  p.wt_down = (bf16_t*)take((size_t)1024 * 2816 * 2);
  p.wt_w2 = (bf16_t*)take((size_t)2 * 512 * 64 * 2);
  p.wt_a2 = (bf16_t*)take((size_t)2 * 512 * 64 * 2);
  p.wt_g2 = (bf16_t*)take((size_t)512 * 128 * 2);
  p.h = (bf16_t*)take((size_t)NTOK * 1024 * 2);
  p.attn_o = p.h;
  p.rwkv_o = p.h + (size_t)NTOK * 512;
  p.projA = (bf16_t*)take((size_t)NTOK * 2560 * 2);
  p.gates = (bf16_t*)take((size_t)NTOK * 2048 * 2);
  p.Y = (float*)p.projA;
  p.act = p.projA;
  p.SH = (bf16_t*)take((size_t)NTOK * 8 * 192 * 2);
  p.DW = (float*)take((size_t)2 * NTOK * 512 * 4);
  p.DK = (bf16_t*)take((size_t)2 * NTOK * 8 * 128 * 2);
  p.up = p.SH;
  p.edge = (bf16_t*)take((size_t)64 * 4 * 5632 * 2);
  p.gbuf = (bf16_t*)take((size_t)NTOK * 512 * 2);
  p.BS = (float*)take((size_t)NTOK * 8 * 2 * 4);
  p.q = (bf16_t*)take((size_t)NTOK * 512 * 2);
  p.Kc = (bf16_t*)take((size_t)16 * 2 * 256 * 64 * 2);
  p.Kl = (bf16_t*)take((size_t)4 * 2 * 1536 * 64 * 2);
  p.Vtc = (bf16_t*)take((size_t)16 * 2 * 256 * 64 * 2);
  p.Vtl = (bf16_t*)take((size_t)4 * 2 * 1536 * 64 * 2);
  p.merged = (bf16_t*)take((size_t)NTOK * 1024 * 2);
  p.bar = (unsigned*)take((XCD_BAR_WORDS + 64) * 4);
  p.never = 0;
  p.pad_ = 0;
  if (off > ws_size) { fprintf(stderr, "workspace too small: need %zu have %zu\n", off, ws_size); return; }
#if FUSED
  static int grid_blocks = 0;
  if (!grid_blocks) {
    int dev = 0, cus = 0, per_cu = 0;
    hipGetDevice(&dev);
    hipDeviceGetAttribute(&cus, hipDeviceAttributeMultiprocessorCount, dev);
    hipOccupancyMaxActiveBlocksPerMultiprocessor(&per_cu, fwd_megakernel, 256, 0);
    if (per_cu > 2) per_cu = 2;
    if (per_cu < 1) per_cu = 1;
    grid_blocks = cus * per_cu;
  }
  void* args[] = {&p};
  hipError_t e = hipLaunchCooperativeKernel((void*)fwd_megakernel, dim3(grid_blocks), dim3(256), args, 0, stream);
  if (e != hipSuccess) fprintf(stderr, "cooperative launch failed: %s (grid %d)\n", hipGetErrorString(e), grid_blocks);
#else
  const int G = 1024;
  phase_kernel<0><<<G, 256, 0, stream>>>(p);
  phase_kernel<1><<<G, 256, 0, stream>>>(p);
  phase_kernel<2><<<G, 256, 0, stream>>>(p);
  phase_kernel<3><<<G, 256, 0, stream>>>(p);
  phase_kernel<4><<<512, 256, 0, stream>>>(p);
  phase_kernel<5><<<G, 256, 0, stream>>>(p);
  phase_kernel<6><<<G, 256, 0, stream>>>(p);
  phase_kernel<7><<<G, 256, 0, stream>>>(p);
  phase_kernel<8><<<G, 256, 0, stream>>>(p);
  phase_kernel<9><<<G, 256, 0, stream>>>(p);
  phase_kernel<10><<<G, 256, 0, stream>>>(p);
  phase_kernel<11><<<G, 256, 0, stream>>>(p);
  phase_kernel<12><<<G, 256, 0, stream>>>(p);
#endif
}
```

```cpp
#include <hip/hip_runtime.h>
#include <hip/hip_cooperative_groups.h>
#include <cstdio>
namespace cg = cooperative_groups;

#ifndef FUSED
#define FUSED 1
#endif

typedef unsigned short bf16_t;
typedef __attribute__((ext_vector_type(8))) short bf16x8;
typedef __attribute__((ext_vector_type(16))) float f32x16;
typedef __attribute__((ext_vector_type(2))) float f32x2;
typedef __attribute__((ext_vector_type(2))) __bf16 bf16x2_t;

#define DI __device__ __forceinline__
#define MFMA(a, b, c) __builtin_amdgcn_mfma_f32_32x32x16_bf16((a), (b), (c), 0, 0, 0)

#define NTOK 8192
#define QSCALE 0.18033688011112042f

struct Params {
  const float *x_prompt, *x_sample, *cache_k, *cache_v, *state, *c, *c_ctx, *w_ada, *b_ada, *norm1_g, *w_in,
      *q_norm_g, *k_norm_g, *rwkv_conv, *w0, *w2, *a0, *a2, *g2, *k_k, *k_a, *r_k, *ln_g, *ln_b, *w_attn_br,
      *w_rwkv_br, *w_out, *norm2_g, *ffn_up, *ffn_conv, *ffn_down, *final_g;
  float* out;
  float* mod;
  bf16_t *wt_in, *wt_attn, *wt_rwkv, *wt_out, *wt_up, *wt_down, *wt_w2, *wt_a2, *wt_g2;
  bf16_t* h;
  bf16_t *attn_o, *rwkv_o;
  bf16_t* projA;
  bf16_t* gates;
  float* Y;
  bf16_t* act;
  bf16_t* SH;
  float* DW;
  bf16_t* DK;
  bf16_t* up;
  bf16_t* edge;
  bf16_t* gbuf;
  float* BS;
  bf16_t* q;
  bf16_t *Kc, *Kl, *Vtc, *Vtl;
  bf16_t* merged;
  unsigned* bar;
  int never;
  int pad_;
};

DI unsigned pack2(float a, float b) {
  f32x2 v = {a, b};
  bf16x2_t r = __builtin_convertvector(v, bf16x2_t);
  return __builtin_bit_cast(unsigned, r);
}
DI bf16_t f2bf(float a) { return (bf16_t)(pack2(a, 0.f) & 0xffffu); }
DI float bflo(unsigned u) { return __uint_as_float(u << 16); }
DI float bfhi(unsigned u) { return __uint_as_float(u & 0xffff0000u); }
DI float bf2f(bf16_t b) { return __uint_as_float(((unsigned)b) << 16); }

template <int CTRL> DI float dppf(float x) {
  return __int_as_float(__builtin_amdgcn_update_dpp(0, __float_as_int(x), CTRL, 0xF, 0xF, true));
}
DI float red8(float x) {
  x += dppf<0xB1>(x);
  x += dppf<0x4E>(x);
  x += dppf<0x141>(x);
  return x;
}
DI float wave_sum(float x) {
#pragma unroll
  for (int o = 32; o >= 1; o >>= 1) x += __shfl_xor(x, o);
  return x;
}
DI const float* xrow(const Params& p, int tok) {
  return tok < 4096 ? p.x_prompt + (size_t)tok * 1024 : p.x_sample + (size_t)(tok - 4096) * 1024;
}
DI int modrow(int tok) { return tok < 4096 ? 0 : 1 + ((tok - 4096) >> 10); }
DI float sigmoidf_(float x) { return __builtin_amdgcn_rcpf(1.f + __expf(-x)); }

typedef __attribute__((ext_vector_type(2))) unsigned u32x2_t;
typedef __attribute__((ext_vector_type(4))) float f32x4_t;
DI void nt_store2(void* p, unsigned a, unsigned b) { u32x2_t v = {a, b}; __builtin_nontemporal_store(v, (u32x2_t*)p); }
DI void nt_store4f(void* p, float a, float b, float c, float d) { f32x4_t v = {a, b, c, d}; __builtin_nontemporal_store(v, (f32x4_t*)p); }
DI size_t SHidx(int tok, int hd, int arr, int c4g) { return ((((size_t)(hd * 256 + (tok >> 5)) * 3 + arr) * 16 + c4g) * 32 + (tok & 31)) * 4; }
DI size_t DKidx(int d, int tok, int hd, int arr, int c4g) { return ((((size_t)((d * 8 + hd) * 256 + (tok >> 5)) * 2 + arr) * 16 + c4g) * 32 + (tok & 31)) * 4; }
DI size_t DWidx(int d, int tok, int hd, int c4g) { return (((size_t)((d * 8 + hd) * 256 + (tok >> 5)) * 16 + c4g) * 32 + (tok & 31)) * 4; }
DI size_t Gidx(int tok, int hd, int c4g) { return (((size_t)(hd * 256 + (tok >> 5)) * 16 + c4g) * 32 + (tok & 31)) * 4; }
DI size_t BSidx(int tok, int hd) { return ((size_t)hd * NTOK + tok) * 2; }

DI void transpose_tile(const float* __restrict__ W, bf16_t* __restrict__ Wt, int K, int N, int tile, char* smem, const bool ugperm = false) {
  const int tid = threadIdx.x;
  const int ntn = N >> 6;
  const int tk = tile / ntn, tn = tile - tk * ntn;
  const int k0 = tk * 64, n0 = tn * 64;
  float* t = (float*)smem;
  const int tx = tid & 15, ty = tid >> 4;
#pragma unroll
  for (int i = 0; i < 4; ++i) {
    int k = ty + 16 * i;
    float4 v = *(const float4*)(W + (size_t)(k0 + k) * N + n0 + tx * 4);
    t[k * 65 + tx * 4 + 0] = v.x; t[k * 65 + tx * 4 + 1] = v.y; t[k * 65 + tx * 4 + 2] = v.z; t[k * 65 + tx * 4 + 3] = v.w;
  }
  __syncthreads();
  const int n = tid >> 2, kc = tid & 3;
  unsigned o[8];
#pragma unroll
  for (int j = 0; j < 8; ++j) o[j] = pack2(t[(kc * 16 + 2 * j) * 65 + n], t[(kc * 16 + 2 * j + 1) * 65 + n]);
  int drow = n0 + n;
  if (ugperm) {
    const bool isg = n0 >= 2816;
    const int cc = (isg ? n0 - 2816 : n0) + n;
    drow = (cc >> 6) * 128 + ((cc >> 5) & 1) * 64 + (isg ? 32 : 0) + (cc & 31);
  }
  uint4* dst = (uint4*)(Wt + (size_t)drow * K + k0 + kc * 16);
  dst[0] = make_uint4(o[0], o[1], o[2], o[3]);
  dst[1] = make_uint4(o[4], o[5], o[6], o[7]);
  __syncthreads();
}

#define P0_MOD_UNITS 384
#define P0_UNITS (P0_MOD_UNITS + 1152 + 128 + 128 + 256 + 1408 + 704 + 16 + 16 + 16)
DI void phase0(const Params& p, int u, char* smem) {
  const int tid = threadIdx.x;
  if (u < P0_MOD_UNITS) {
    float* sc = (float*)smem;
    float* red = sc + 5 * 1024;
    for (int i = tid; i < 5 * 1024; i += 256) {
      int r = i >> 10, k = i & 1023;
      float cv = (r == 0) ? p.c_ctx[k] : p.c[(r - 1) * 1024 + k];
      sc[i] = cv / (1.f + __expf(-cv));
    }
    __syncthreads();
    const int cgp = tid & 3, kg = tid >> 2;
    const int n = u * 16 + cgp * 4;
    float4 acc[5];
#pragma unroll
    for (int r = 0; r < 5; ++r) acc[r] = make_float4(0.f, 0.f, 0.f, 0.f);
#pragma unroll
    for (int kk = 0; kk < 16; ++kk) {
      int k = kg * 16 + kk;
      float4 w = *(const float4*)(p.w_ada + (size_t)k * 6144 + n);
#pragma unroll
      for (int r = 0; r < 5; ++r) {
        float s = sc[r * 1024 + k];
        acc[r].x += s * w.x; acc[r].y += s * w.y; acc[r].z += s * w.z; acc[r].w += s * w.w;
      }
    }
#pragma unroll
    for (int r = 0; r < 5; ++r) {
      float* d = red + (kg * 5 + r) * 16 + cgp * 4;
      d[0] = acc[r].x; d[1] = acc[r].y; d[2] = acc[r].z; d[3] = acc[r].w;
    }
    __syncthreads();
    if (tid < 80) {
      int r = tid >> 4, ci = tid & 15;
      float s = p.b_ada[u * 16 + ci];
      for (int g = 0; g < 64; ++g) s += red[(g * 5 + r) * 16 + ci];
      p.mod[r * 6144 + u * 16 + ci] = s;
    }
    __syncthreads();
    return;
  }
  int t = u - P0_MOD_UNITS;
  if (t < 1152) { transpose_tile(p.w_in, p.wt_in, 1024, 4608, t, smem); return; }
  t -= 1152;
  if (t < 128) { transpose_tile(p.w_attn_br, p.wt_attn, 512, 1024, t, smem); return; }
  t -= 128;
  if (t < 128) { transpose_tile(p.w_rwkv_br, p.wt_rwkv, 512, 1024, t, smem); return; }
  t -= 128;
  if (t < 256) { transpose_tile(p.w_out, p.wt_out, 1024, 1024, t, smem); return; }
  t -= 256;
  if (t < 1408) { transpose_tile(p.ffn_up, p.wt_up, 1024, 5632, t, smem, true); return; }
  t -= 1408;
  if (t < 704) { transpose_tile(p.ffn_down, p.wt_down, 2816, 1024, t, smem); return; }
  t -= 704;
  if (t < 16) { int d = t >> 3; transpose_tile(p.w2 + d * 64 * 512, p.wt_w2 + d * 512 * 64, 64, 512, t & 7, smem); return; }
  t -= 16;
  if (t < 16) { int d = t >> 3; transpose_tile(p.a2 + d * 64 * 512, p.wt_a2 + d * 512 * 64, 64, 512, t & 7, smem); return; }
  t -= 16;
  transpose_tile(p.g2, p.wt_g2, 128, 512, t, smem);
}

template <int MODE> DI void norm_rows(const Params& p, int u) {
  const int tid = threadIdx.x, wave = tid >> 6, lane = tid & 63;
  const int tok0 = u * 16 + wave * 4;
  float4 v[4][4];
#pragma unroll
  for (int rr = 0; rr < 4; ++rr) {
    const float* xr = (MODE == 0) ? xrow(p, tok0 + rr) : p.out + (size_t)(tok0 + rr) * 1024;
#pragma unroll
    for (int i = 0; i < 4; ++i) v[rr][i] = *(const float4*)(xr + lane * 4 + 256 * i);
  }
  const float* g = (MODE == 0) ? p.norm1_g : (MODE == 1) ? p.norm2_g : p.final_g;
  float4 gg[4];
#pragma unroll
  for (int i = 0; i < 4; ++i) gg[i] = *(const float4*)(g + lane * 4 + 256 * i);
  const float* mr = p.mod + modrow(tok0) * 6144 + (MODE == 1 ? 3 * 1024 : 0);
  float4 sh[4], scl[4];
  if (MODE < 2) {
#pragma unroll
    for (int i = 0; i < 4; ++i) { sh[i] = *(const float4*)(mr + lane * 4 + 256 * i); scl[i] = *(const float4*)(mr + 1024 + lane * 4 + 256 * i); }
  }
#pragma unroll
  for (int rr = 0; rr < 4; ++rr) {
    const int tok = tok0 + rr;
    float ss = 0.f;
#pragma unroll
    for (int i = 0; i < 4; ++i) ss += v[rr][i].x * v[rr][i].x + v[rr][i].y * v[rr][i].y + v[rr][i].z * v[rr][i].z + v[rr][i].w * v[rr][i].w;
    ss = wave_sum(ss);
    const float rstd = rsqrtf(ss * (1.f / 1024.f) + 1e-6f);
#pragma unroll
    for (int i = 0; i < 4; ++i) {
      int c = lane * 4 + 256 * i;
      float y0 = v[rr][i].x * rstd * gg[i].x, y1 = v[rr][i].y * rstd * gg[i].y, y2 = v[rr][i].z * rstd * gg[i].z, y3 = v[rr][i].w * rstd * gg[i].w;
      if (MODE < 2) {
        y0 = y0 * (1.f + scl[i].x) + sh[i].x; y1 = y1 * (1.f + scl[i].y) + sh[i].y; y2 = y2 * (1.f + scl[i].z) + sh[i].z; y3 = y3 * (1.f + scl[i].w) + sh[i].w;
        *(uint2*)(p.h + (size_t)tok * 1024 + c) = make_uint2(pack2(y0, y1), pack2(y2, y3));
      } else {
        *(float4*)(p.out + (size_t)tok * 1024 + c) = make_float4(y0, y1, y2, y3);
      }
    }
  }
}

DI void gemm_mainloop(f32x16 (&acc)[2][2], const bf16_t* __restrict__ A, int lda, const bf16_t* __restrict__ Bt, int ldb, int K, char* smem) {
  const int tid = threadIdx.x, lane = tid & 63, wave = tid >> 6;
  const int wm = wave >> 1, wn = wave & 1;
  const int lr = tid >> 3, lc = tid & 7;
  const bf16_t* ap = A + (size_t)lr * lda + lc * 8;
  const bf16_t* bp = Bt + (size_t)lr * ldb + lc * 8;
  const int woff = lr * 128 + ((lc ^ (lr & 7)) << 4);
  const size_t sa = (size_t)32 * lda, sb = (size_t)32 * ldb;
  uint4 a0, a1, a2, a3, b0, b1, b2, b3;
  uint4 c0, c1, c2, c3, d0, d1, d2, d3;
#define GL0(k0) do { a0 = *(const uint4*)(ap + (k0)); a1 = *(const uint4*)(ap + sa + (k0)); a2 = *(const uint4*)(ap + 2 * sa + (k0)); a3 = *(const uint4*)(ap + 3 * sa + (k0)); \
                     b0 = *(const uint4*)(bp + (k0)); b1 = *(const uint4*)(bp + sb + (k0)); b2 = *(const uint4*)(bp + 2 * sb + (k0)); b3 = *(const uint4*)(bp + 3 * sb + (k0)); } while (0)
#define GL1(k0) do { c0 = *(const uint4*)(ap + (k0)); c1 = *(const uint4*)(ap + sa + (k0)); c2 = *(const uint4*)(ap + 2 * sa + (k0)); c3 = *(const uint4*)(ap + 3 * sa + (k0)); \
                     d0 = *(const uint4*)(bp + (k0)); d1 = *(const uint4*)(bp + sb + (k0)); d2 = *(const uint4*)(bp + 2 * sb + (k0)); d3 = *(const uint4*)(bp + 3 * sb + (k0)); } while (0)
#define SW0(buf) do { char* w_ = smem + (buf) * 32768 + woff; *(uint4*)(w_) = a0; *(uint4*)(w_ + 4096) = a1; *(uint4*)(w_ + 8192) = a2; *(uint4*)(w_ + 12288) = a3; \
                      *(uint4*)(w_ + 16384) = b0; *(uint4*)(w_ + 20480) = b1; *(uint4*)(w_ + 24576) = b2; *(uint4*)(w_ + 28672) = b3; } while (0)
#define SW1(buf) do { char* w_ = smem + (buf) * 32768 + woff; *(uint4*)(w_) = c0; *(uint4*)(w_ + 4096) = c1; *(uint4*)(w_ + 8192) = c2; *(uint4*)(w_ + 12288) = c3; \
                      *(uint4*)(w_ + 16384) = d0; *(uint4*)(w_ + 20480) = d1; *(uint4*)(w_ + 24576) = d2; *(uint4*)(w_ + 28672) = d3; } while (0)
  const int l31 = lane & 31, hh = lane >> 5, l7 = lane & 7;
  const int arow = (wm * 64 + l31) * 128, brow = 16384 + (wn * 64 + l31) * 128;
#define COMPUTE(buf) do { const char* as_ = smem + (buf) * 32768; \
    _Pragma("unroll") for (int ks = 0; ks < 4; ++ks) { \
      const int ch = ((ks * 2 + hh) ^ l7) << 4; \
      bf16x8 af0 = *(const bf16x8*)(as_ + arow + ch), af1 = *(const bf16x8*)(as_ + arow + 4096 + ch); \
      bf16x8 bf0 = *(const bf16x8*)(as_ + brow + ch), bf1 = *(const bf16x8*)(as_ + brow + 4096 + ch); \
      acc[0][0] = MFMA(af0, bf0, acc[0][0]); acc[0][1] = MFMA(af0, bf1, acc[0][1]); \
      acc[1][0] = MFMA(af1, bf0, acc[1][0]); acc[1][1] = MFMA(af1, bf1, acc[1][1]); } } while (0)
  const int nk = K >> 6;
  const int klast = (nk - 1) * 64;
  GL0(0);
  SW0(0);
  GL0(64);
  GL1(min(128, klast));
  __syncthreads();
  for (int kt = 0; kt < nk; kt += 2) {
    COMPUTE(0);
    SW0(1);
    GL0(min((kt + 3) * 64, klast));
    __syncthreads();
    COMPUTE(1);
    SW1(0);
    GL1(min((kt + 4) * 64, klast));
    __syncthreads();
  }
#undef GL0
#undef GL1
#undef SW0
#undef SW1
#undef COMPUTE
}

DI void zero_acc(f32x16 (&acc)[2][2]) {
#pragma unroll
  for (int i = 0; i < 2; ++i)
#pragma unroll
    for (int j = 0; j < 2; ++j)
#pragma unroll
      for (int r = 0; r < 16; ++r) acc[i][j][r] = 0.f;
}

template <int EPI> DI void gemm_unit(const Params& p, int u, char* smem) {
  const int mt = u & 63, nt = u >> 6;
  const int m0 = mt * 128, n0 = nt * 128;
  const int tid = threadIdx.x, lane = tid & 63, wave = tid >> 6;
  const int wm = wave >> 1, wn = wave & 1, l31 = lane & 31, hh = lane >> 5;
  f32x16 acc[2][2];
  zero_acc(acc);
  if (EPI == 0) gemm_mainloop(acc, p.h + (size_t)m0 * 1024, 1024, p.wt_in + (size_t)n0 * 1024, 1024, 1024, smem);
  if (EPI == 2) gemm_mainloop(acc, p.merged + (size_t)m0 * 1024, 1024, p.wt_out + (size_t)n0 * 1024, 1024, 1024, smem);
  if (EPI == 3) gemm_mainloop(acc, p.h + (size_t)m0 * 1024, 1024, p.wt_up + (size_t)n0 * 1024, 1024, 1024, smem);
  if (EPI == 4) gemm_mainloop(acc, p.act + (size_t)m0 * 2816, 2816, p.wt_down + (size_t)n0 * 2816, 2816, 2816, smem);
  if (EPI == 1) gemm_mainloop(acc, p.attn_o + (size_t)m0 * 512, 512, p.wt_attn + (size_t)n0 * 512, 512, 512, smem);
  if (EPI == 5) gemm_mainloop(acc, p.rwkv_o + (size_t)m0 * 512, 512, p.wt_rwkv + (size_t)n0 * 512, 512, 512, smem);
  float* et = (float*)smem;
#pragma unroll
  for (int i = 0; i < 2; ++i)
#pragma unroll
    for (int j = 0; j < 2; ++j)
#pragma unroll
      for (int r = 0; r < 16; ++r)
        et[(wm * 64 + i * 32 + (r & 3) + 8 * (r >> 2) + 4 * hh) * 132 + wn * 64 + j * 32 + l31] = acc[i][j][r];
  __syncthreads();
#pragma unroll 4
  for (int it = 0; it < 16; ++it) {
    const int id = tid + 256 * it;
    const int row = id >> 5, c4 = (id & 31) * 4;
    const float4 v = *(const float4*)(et + row * 132 + c4);
    const int m = m0 + row, n = n0 + c4;
    if (EPI == 0) {
      const uint2 o = make_uint2(pack2(v.x, v.y), pack2(v.z, v.w));
      if (n0 < 2560) *(uint2*)(p.projA + (size_t)m * 2560 + n) = o;
      else *(uint2*)(p.gates + (size_t)m * 2048 + (n - 2560)) = o;
    } else if (EPI == 1) {
      const uint2 g = *(const uint2*)(p.gates + (size_t)m * 2048 + n);
      *(uint2*)(p.merged + (size_t)m * 1024 + n) = make_uint2(pack2(v.x * sigmoidf_(bflo(g.x)), v.y * sigmoidf_(bfhi(g.x))),
                                                             pack2(v.z * sigmoidf_(bflo(g.y)), v.w * sigmoidf_(bfhi(g.y))));
    } else if (EPI == 5) {
      const uint2 g = *(const uint2*)(p.gates + (size_t)m * 2048 + 1024 + n);
      uint2* mp = (uint2*)(p.merged + (size_t)m * 1024 + n);
      const uint2 o = *mp;
      *mp = make_uint2(pack2(bflo(o.x) + v.x * sigmoidf_(bflo(g.x)), bfhi(o.x) + v.y * sigmoidf_(bfhi(g.x))),
                       pack2(bflo(o.y) + v.z * sigmoidf_(bflo(g.y)), bfhi(o.y) + v.w * sigmoidf_(bfhi(g.y))));
    } else if (EPI == 2) {
      const float4 g1 = *(const float4*)(p.mod + modrow(m) * 6144 + 2 * 1024 + n);
      const float4 x = *(const float4*)(xrow(p, m) + n);
      *(float4*)(p.out + (size_t)m * 1024 + n) = make_float4(x.x + g1.x * v.x, x.y + g1.y * v.y, x.z + g1.z * v.z, x.w + g1.w * v.w);
    } else if (EPI == 3) {
      *(uint2*)(p.up + (size_t)m * 5632 + n) = make_uint2(pack2(v.x, v.y), pack2(v.z, v.w));
    } else {
      const float4 g2 = *(const float4*)(p.mod + modrow(m) * 6144 + 5 * 1024 + n);
      float4* o = (float4*)(p.out + (size_t)m * 1024 + n);
      const float4 x = *o;
      *o = make_float4(x.x + g2.x * v.x, x.y + g2.y * v.y, x.z + g2.z * v.z, x.w + g2.w * v.w);
    }
  }
  __syncthreads();
}

#define WPITCH 80
#define WSTAGE (384 * WPITCH)
DI void gemm_mainloop_wide(f32x16 (&acc)[4][2], const bf16_t* __restrict__ A, const bf16_t* __restrict__ Bt, char* smem) {
  const int tid = threadIdx.x, lane = tid & 63, wave = tid >> 6;
  const int wm = wave >> 1, wn = wave & 1;
  const int lr = tid >> 2, lc = tid & 3;
  const bf16_t* ap = A + (size_t)lr * 1024 + lc * 8;
  const bf16_t* bp = Bt + (size_t)lr * 1024 + lc * 8;
  const int woff = lr * WPITCH + lc * 16;
  const size_t st64 = (size_t)64 * 1024;
  uint4 a0, a1, a2, a3, b0, b1;
  uint4 c0, c1, c2, c3, d0, d1;
#define WGL0(k0) do { a0 = *(const uint4*)(ap + (k0)); a1 = *(const uint4*)(ap + st64 + (k0)); a2 = *(const uint4*)(ap + 2 * st64 + (k0)); a3 = *(const uint4*)(ap + 3 * st64 + (k0)); \
                      b0 = *(const uint4*)(bp + (k0)); b1 = *(const uint4*)(bp + st64 + (k0)); } while (0)
#define WGL1(k0) do { c0 = *(const uint4*)(ap + (k0)); c1 = *(const uint4*)(ap + st64 + (k0)); c2 = *(const uint4*)(ap + 2 * st64 + (k0)); c3 = *(const uint4*)(ap + 3 * st64 + (k0)); \
                      d0 = *(const uint4*)(bp + (k0)); d1 = *(const uint4*)(bp + st64 + (k0)); } while (0)
#define WSW0(buf) do { char* w_ = smem + (buf) * WSTAGE + woff; *(uint4*)(w_) = a0; *(uint4*)(w_ + 64 * WPITCH) = a1; *(uint4*)(w_ + 128 * WPITCH) = a2; *(uint4*)(w_ + 192 * WPITCH) = a3; \
                       *(uint4*)(w_ + 256 * WPITCH) = b0; *(uint4*)(w_ + 320 * WPITCH) = b1; } while (0)
#define WSW1(buf) do { char* w_ = smem + (buf) * WSTAGE + woff; *(uint4*)(w_) = c0; *(uint4*)(w_ + 64 * WPITCH) = c1; *(uint4*)(w_ + 128 * WPITCH) = c2; *(uint4*)(w_ + 192 * WPITCH) = c3; \
                       *(uint4*)(w_ + 256 * WPITCH) = d0; *(uint4*)(w_ + 320 * WPITCH) = d1; } while (0)
  const int l31 = lane & 31, hh = lane >> 5;
  const int arow = (wm * 128 + l31) * WPITCH, brow = (256 + wn * 64 + l31) * WPITCH;
#define WCOMPUTE(buf) do { const char* as_ = smem + (buf) * WSTAGE; \
    _Pragma("unroll") for (int ks = 0; ks < 2; ++ks) { \
      const int ch = (ks * 2 + hh) * 16; \
      bf16x8 bf0 = *(const bf16x8*)(as_ + brow + ch), bf1 = *(const bf16x8*)(as_ + brow + 32 * WPITCH + ch); \
      _Pragma("unroll") for (int i = 0; i < 4; ++i) { \
        bf16x8 af = *(const bf16x8*)(as_ + arow + i * 32 * WPITCH + ch); \
        acc[i][0] = MFMA(af, bf0, acc[i][0]); acc[i][1] = MFMA(af, bf1, acc[i][1]); } } } while (0)
  const int nk = 32;
  const int klast = (nk - 1) * 32;
  WGL0(0);
  WSW0(0);
  WGL0(32);
  WGL1(64);
  __syncthreads();
  for (int kt = 0; kt < nk; kt += 2) {
    WCOMPUTE(0);
    WSW0(1);
    WGL0(min((kt + 3) * 32, klast));
    __syncthreads();
    WCOMPUTE(1);
    WSW1(0);
    WGL1(min((kt + 4) * 32, klast));
    __syncthreads();
  }
#undef WGL0
#undef WGL1
#undef WSW0
#undef WSW1
#undef WCOMPUTE
}

template <int EPI> DI void gemm_unit_wide(const Params& p, int mt, int nt, char* smem) {
  const int m0 = mt * 256, n0 = nt * 128;
  const int tid = threadIdx.x, lane = tid & 63, wave = tid >> 6;
  const int wm = wave >> 1, wn = wave & 1, l31 = lane & 31, hh = lane >> 5;
  f32x16 acc[4][2];
#pragma unroll
  for (int i = 0; i < 4; ++i)
#pragma unroll
    for (int j = 0; j < 2; ++j)
#pragma unroll
      for (int r = 0; r < 16; ++r) acc[i][j][r] = 0.f;
  gemm_mainloop_wide(acc, p.h + (size_t)m0 * 1024, (EPI == 0 ? p.wt_in : p.wt_up) + (size_t)n0 * 1024, smem);
#pragma unroll
  for (int i = 0; i < 4; ++i)
#pragma unroll
    for (int j = 0; j < 2; ++j)
#pragma unroll
      for (int r = 0; r < 16; ++r) {
        if ((r & 7) == 0) asm volatile("" ::: "memory");
        const int m = m0 + wm * 128 + i * 32 + (r & 3) + 8 * (r >> 2) + 4 * hh;
        const int n = n0 + wn * 64 + j * 32 + l31;
        const float a = acc[i][j][r];
        (void)m; (void)n; (void)a;
      }
  if (EPI == 0) {
    char* wl = smem + wave * (128 * 144);
#pragma unroll
    for (int i = 0; i < 4; ++i)
#pragma unroll
      for (int j = 0; j < 2; ++j)
#pragma unroll
        for (int r = 0; r < 16; ++r) {
          const int row = i * 32 + (r & 3) + 8 * (r >> 2) + 4 * hh;
          *(bf16_t*)(wl + row * 144 + (j * 32 + l31) * 2) = f2bf(acc[i][j][r]);
        }
    __syncthreads();
    const int rr = lane >> 3, cc = lane & 7;
    bf16_t* dst = (n0 < 2560) ? p.projA + (size_t)(m0 + wm * 128) * 2560 + n0 + wn * 64 + cc * 8
                              : p.gates + (size_t)(m0 + wm * 128) * 2048 + (n0 - 2560) + wn * 64 + cc * 8;
    const size_t ldd = (n0 < 2560) ? 2560 : 2048;
#pragma unroll
    for (int it = 0; it < 16; ++it) {
      const int row = it * 8 + rr;
      *(uint4*)(dst + (size_t)row * ldd) = *(const uint4*)(wl + row * 144 + cc * 16);
    }
    __syncthreads();
  }
  if (EPI == 3) {
    char* wl = smem + wave * 16384;
#pragma unroll
    for (int i = 0; i < 4; ++i)
#pragma unroll
      for (int r = 0; r < 16; ++r) {
        const int row = i * 32 + (r & 3) + 8 * (r >> 2) + 4 * hh;
        *(bf16_t*)(wl + row * 64 + l31 * 2) = f2bf(acc[i][0][r]);
        *(bf16_t*)(wl + 8192 + row * 64 + l31 * 2) = f2bf(acc[i][1][r]);
      }
    __syncthreads();
    const int ch = lane & 31, half = lane >> 5;
    const int chg = nt * 64 + wn * 32 + ch;
    const float wu0 = p.ffn_conv[chg], wu1 = p.ffn_conv[5632 + chg], wu2 = p.ffn_conv[2 * 5632 + chg];
    const float wg0 = p.ffn_conv[2816 + chg], wg1 = p.ffn_conv[5632 + 2816 + chg], wg2 = p.ffn_conv[2 * 5632 + 2816 + chg];
    const int blk = mt * 2 + wm;
    const int rb = half * 64;
    const char* ul = wl + ch * 2;
    const char* gl = wl + 8192 + ch * 2;
    bf16_t pu = rb ? *(const bf16_t*)(ul + (rb - 1) * 64) : (bf16_t)0, pg = rb ? *(const bf16_t*)(gl + (rb - 1) * 64) : (bf16_t)0;
    bf16_t cu = *(const bf16_t*)(ul + rb * 64), cg = *(const bf16_t*)(gl + rb * 64);
#pragma unroll 8
    for (int q = 0; q < 64; ++q) {
      const int L = rb + q;
      bf16_t nu = 0, ng = 0;
      if (L < 127) { nu = *(const bf16_t*)(ul + (L + 1) * 64); ng = *(const bf16_t*)(gl + (L + 1) * 64); }
      if (L == 0 || L == 1 || L == 126 || L == 127) {
        bf16_t* e = p.edge + ((size_t)blk * 4 + (L < 2 ? L : L - 124)) * 5632;
        e[chg] = cu; e[2816 + chg] = cg;
      }
      if (L != 0 && L != 127) {
        const float uu = bf2f(pu) * wu0 + bf2f(cu) * wu1 + bf2f(nu) * wu2;
        const float gg = bf2f(pg) * wg0 + bf2f(cg) * wg1 + bf2f(ng) * wg2;
        p.act[(size_t)(blk * 128 + L) * 2816 + chg] = f2bf(gg * sigmoidf_(gg) * uu);
      }
      pu = cu; pg = cg; cu = nu; cg = ng;
    }
    __syncthreads();
  }
}

DI void load4bf(const bf16_t* p, float (&o)[4]) {
  uint2 v = *(const uint2*)p;
  o[0] = bflo(v.x); o[1] = bfhi(v.x); o[2] = bflo(v.y); o[3] = bfhi(v.y);
}
struct APIn { uint2 qlo, qhi, klo, khi; };
DI APIn attn_prep_load(const Params& p, int tok, int lane) {
  const bf16_t* pr = p.projA + (size_t)tok * 2560;
  const int sub = lane & 7, hd = lane >> 3, kvh = (lane >> 3) & 1;
  APIn r;
  r.qlo = *(const uint2*)(pr + hd * 64 + sub * 4);
  r.qhi = *(const uint2*)(pr + hd * 64 + 32 + sub * 4);
  r.klo = *(const uint2*)(pr + 512 + kvh * 64 + sub * 4);
  r.khi = *(const uint2*)(pr + 512 + kvh * 64 + 32 + sub * 4);
  return r;
}
DI void unpk4(uint2 v, float (&o)[4]) { o[0] = bflo(v.x); o[1] = bfhi(v.x); o[2] = bflo(v.y); o[3] = bfhi(v.y); }
DI void attn_prep_token(const Params& p, int tok, int lane, const APIn& in) {
  const int sub = lane & 7;
  const bool latent = tok >= 4096;
  int s, t, L;
  if (!latent) { s = tok >> 8; t = tok & 255; L = 256; }
  else { s = (tok - 4096) >> 10; t = (tok - 4096) & 1023; L = 1024; }
  float cs[4], sn[4];
  if (latent) {
    const int row = t >> 6, col = t & 63;
#pragma unroll
    for (int i = 0; i < 4; ++i) {
      int pi = sub * 4 + i;
      float inv = __builtin_amdgcn_exp2f(-(float)(pi & 15) * 0.83048202372184059f);
      float ang = (pi < 16 ? (float)row : (float)col) * inv;
      sn[i] = __sinf(ang); cs[i] = __cosf(ang);
    }
  }
  {
    const int hd = lane >> 3;
    float lo[4], hi[4];
    unpk4(in.qlo, lo);
    unpk4(in.qhi, hi);
    float ss = 0.f;
#pragma unroll
    for (int i = 0; i < 4; ++i) ss += lo[i] * lo[i] + hi[i] * hi[i];
    ss = red8(ss);
    const float rinv = rsqrtf(ss * (1.f / 64.f) + 1e-6f);
    float4 gl = *(const float4*)(p.q_norm_g + sub * 4), gh = *(const float4*)(p.q_norm_g + 32 + sub * 4);
    const float glv[4] = {gl.x, gl.y, gl.z, gl.w}, ghv[4] = {gh.x, gh.y, gh.z, gh.w};
#pragma unroll
    for (int i = 0; i < 4; ++i) {
      float a = lo[i] * rinv * glv[i], b = hi[i] * rinv * ghv[i];
      if (latent) { float na = a * cs[i] - b * sn[i]; float nb = b * cs[i] + a * sn[i]; a = na; b = nb; }
      lo[i] = a * QSCALE; hi[i] = b * QSCALE;
    }
    size_t qo = latent ? (size_t)4096 * 512 + ((size_t)(s * 8 + hd) * 1024 + t) * 64 : ((size_t)(s * 8 + hd) * 256 + t) * 64;
    *(uint2*)(p.q + qo + sub * 4) = make_uint2(pack2(lo[0], lo[1]), pack2(lo[2], lo[3]));
    *(uint2*)(p.q + qo + 32 + sub * 4) = make_uint2(pack2(hi[0], hi[1]), pack2(hi[2], hi[3]));
  }
  {
    const int kvh = (lane >> 3) & 1;
    float lo[4], hi[4];
    unpk4(in.klo, lo);
    unpk4(in.khi, hi);
    float ss = 0.f;
#pragma unroll
    for (int i = 0; i < 4; ++i) ss += lo[i] * lo[i] + hi[i] * hi[i];
    ss = red8(ss);
    const float rinv = rsqrtf(ss * (1.f / 64.f) + 1e-6f);
    float4 gl = *(const float4*)(p.k_norm_g + sub * 4), gh = *(const float4*)(p.k_norm_g + 32 + sub * 4);
    const float glv[4] = {gl.x, gl.y, gl.z, gl.w}, ghv[4] = {gh.x, gh.y, gh.z, gh.w};
#pragma unroll
    for (int i = 0; i < 4; ++i) { lo[i] = lo[i] * rinv * glv[i]; hi[i] = hi[i] * rinv * ghv[i]; }
    if (lane < 16) {
      if (!latent) {
        float* ok = p.out + (size_t)2 * 4194304 + ((size_t)(s * 2 + kvh) * 256 + t) * 64;
        *(float4*)(ok + sub * 4) = make_float4(lo[0], lo[1], lo[2], lo[3]);
        *(float4*)(ok + 32 + sub * 4) = make_float4(hi[0], hi[1], hi[2], hi[3]);
        bf16_t* kb = p.Kc + ((size_t)(s * 2 + kvh) * 256 + t) * 64;
        *(uint2*)(kb + sub * 4) = make_uint2(pack2(lo[0], lo[1]), pack2(lo[2], lo[3]));
        *(uint2*)(kb + 32 + sub * 4) = make_uint2(pack2(hi[0], hi[1]), pack2(hi[2], hi[3]));
      } else {
#pragma unroll
        for (int i = 0; i < 4; ++i) {
          float a = lo[i], b = hi[i];
          lo[i] = a * cs[i] - b * sn[i]; hi[i] = b * cs[i] + a * sn[i];
        }
        bf16_t* kb = p.Kl + ((size_t)(s * 2 + kvh) * 1536 + t) * 64;
        *(uint2*)(kb + sub * 4) = make_uint2(pack2(lo[0], lo[1]), pack2(lo[2], lo[3]));
        *(uint2*)(kb + 32 + sub * 4) = make_uint2(pack2(hi[0], hi[1]), pack2(hi[2], hi[3]));
      }
    }
  }
  (void)L;
}

DI void attn_prep_unit(const Params& p, int u) {
  int lane = threadIdx.x & 63;
  asm volatile("" : "+v"(lane));
  const int tok0 = u * 16 + (threadIdx.x >> 6) * 4;
  APIn in[4];
#pragma unroll
  for (int i = 0; i < 4; ++i) in[i] = attn_prep_load(p, tok0 + i, lane);
#pragma unroll
  for (int i = 0; i < 4; ++i) attn_prep_token(p, tok0 + i, lane, in[i]);
}

DI void v_prep_unit(const Params& p, int u) {
  int tid = threadIdx.x;
  asm volatile("" : "+v"(tid));
  const int lane = tid & 63, wave = tid >> 6;
  const int tok0 = u * 32 + wave * 8;
  const bool latent = tok0 >= 4096;
  int s, t0, LK;
  if (!latent) { s = tok0 >> 8; t0 = tok0 & 255; LK = 256; }
  else { s = (tok0 - 4096) >> 10; t0 = (tok0 - 4096) & 1023; LK = 1536; }
#pragma unroll
  for (int kvh = 0; kvh < 2; ++kvh) {
    unsigned short raw[8];
#pragma unroll
    for (int j = 0; j < 8; ++j) raw[j] = p.projA[(size_t)(tok0 + j) * 2560 + 640 + kvh * 64 + lane];
    if (!latent) {
      float* ov = p.out + (size_t)2 * 4194304 + 524288 + ((size_t)(s * 2 + kvh) * 256 + t0) * 64 + lane;
#pragma unroll
      for (int j = 0; j < 8; ++j) ov[j * 64] = bf2f(raw[j]);
    }
    bf16_t* vt = (latent ? p.Vtl : p.Vtc) + ((size_t)(s * 2 + kvh) * 64 + lane) * LK + t0;
    *(uint4*)vt = make_uint4((unsigned)raw[0] | ((unsigned)raw[1] << 16), (unsigned)raw[2] | ((unsigned)raw[3] << 16),
                             (unsigned)raw[4] | ((unsigned)raw[5] << 16), (unsigned)raw[6] | ((unsigned)raw[7] << 16));
  }
}

DI void cache_conv_unit(const Params& p, int u, char* smem) {
  int tid = threadIdx.x;
  asm volatile("" : "+v"(tid));
  const int kb = u & 7, bk = u >> 3;
  const float* ck = p.cache_k + ((size_t)bk * 512 + kb * 64) * 64;
  const float* cv = p.cache_v + ((size_t)bk * 512 + kb * 64) * 64;
  float* t = (float*)smem;
  const int tx = tid & 15, ty = tid >> 4;
#pragma unroll
  for (int i = 0; i < 4; ++i) {
    int key = ty + 16 * i;
    float4 kv = *(const float4*)(ck + key * 64 + tx * 4);
    *(uint2*)(p.Kl + ((size_t)bk * 1536 + 1024 + kb * 64 + key) * 64 + tx * 4) = make_uint2(pack2(kv.x, kv.y), pack2(kv.z, kv.w));
    float4 v = *(const float4*)(cv + key * 64 + tx * 4);
    t[key * 65 + tx * 4 + 0] = v.x; t[key * 65 + tx * 4 + 1] = v.y; t[key * 65 + tx * 4 + 2] = v.z; t[key * 65 + tx * 4 + 3] = v.w;
  }
  __syncthreads();
  const int d = tid >> 2, kc = tid & 3;
  unsigned o[8];
#pragma unroll
  for (int j = 0; j < 8; ++j) o[j] = pack2(t[(kc * 16 + 2 * j) * 65 + d], t[(kc * 16 + 2 * j + 1) * 65 + d]);
  uint4* dst = (uint4*)(p.Vtl + ((size_t)bk * 64 + d) * 1536 + 1024 + kb * 64 + kc * 16);
  dst[0] = make_uint4(o[0], o[1], o[2], o[3]);
  dst[1] = make_uint4(o[4], o[5], o[6], o[7]);
  __syncthreads();
}

#define ACT_STRIDE 528
#define RAW_OFF (32 * ACT_STRIDE)
#define RAW_STRIDE 1552
#define SMEM_BYTES (3 * 16 * 384 * 4 + 64)
DI void ld4bf_lds(const char* p, float (&o)[4]) {
  uint2 v = *(const uint2*)p;
  o[0] = bflo(v.x); o[1] = bfhi(v.x); o[2] = bflo(v.y); o[3] = bfhi(v.y);
}
DI void conv4_lds(const char* center, int boff, const float* cw, int cwcol, float (&o)[4]) {
  float c0[4], c1[4], c2[4];
  ld4bf_lds(center - RAW_STRIDE + boff, c0);
  ld4bf_lds(center + boff, c1);
  ld4bf_lds(center + RAW_STRIDE + boff, c2);
  float4 w0 = *(const float4*)(cw + cwcol), w1 = *(const float4*)(cw + 1792 + cwcol), w2 = *(const float4*)(cw + 2 * 1792 + cwcol);
  o[0] = c0[0] * w0.x + c1[0] * w1.x + c2[0] * w2.x;
  o[1] = c0[1] * w0.y + c1[1] * w1.y + c2[1] * w2.y;
  o[2] = c0[2] * w0.z + c1[2] * w1.z + c2[2] * w2.z;
  o[3] = c0[3] * w0.w + c1[3] * w1.w + c2[3] * w2.w;
}

DI void rwkv_prep_unit(const Params& p, int u, char* smem) {
  int tid = threadIdx.x;
  asm volatile("" : "+v"(tid));
  const int lane = tid & 63, wave = tid >> 6;
  const int tile = u >> 1, hg = u & 1;
  const int tok0 = tile * 32;
  int seq_start, L;
  if (tok0 < 4096) { seq_start = tok0 & ~255; L = 256; } else { seq_start = 4096 + ((tok0 - 4096) & ~1023); L = 1024; }
  const int seq_end = seq_start + L;
  {
    uint4 rg[13];
#pragma unroll
    for (int i = 0; i < 13; ++i) {
      const int idx = tid + 256 * i;
      const int row = idx / 96, rem = idx - row * 96;
      const int arr = rem >> 5, q = rem & 31;
      const int tk = tok0 - 1 + row;
      rg[i] = make_uint4(0, 0, 0, 0);
      if (idx < 34 * 96 && tk >= seq_start && tk < seq_end)
        rg[i] = *(const uint4*)(p.projA + (size_t)tk * 2560 + 768 + arr * 512 + hg * 256 + q * 8);
    }
    const int col = tid;
    const int pc = 2304 + col;
    const float w0 = p.rwkv_conv[1536 + col], w1 = p.rwkv_conv[1792 + 1536 + col], w2 = p.rwkv_conv[2 * 1792 + 1536 + col];
    float xv[18];
#pragma unroll
    for (int i = 0; i < 18; ++i) {
      const int tk = tok0 - 1 + i;
      xv[i] = (tk >= seq_start && tk < seq_end) ? bf2f(p.projA[(size_t)tk * 2560 + pc]) : 0.f;
    }
#pragma unroll
    for (int i = 0; i < 13; ++i) {
      const int idx = tid + 256 * i;
      const int row = idx / 96, rem = idx - row * 96;
      if (idx < 34 * 96) *(uint4*)(smem + RAW_OFF + row * RAW_STRIDE + rem * 16) = rg[i];
    }
#pragma unroll 1
    for (int half = 0; half < 2; ++half) {
      float xn[18];
      if (half == 0) {
#pragma unroll
        for (int i = 0; i < 18; ++i) {
          const int tk = tok0 + 15 + i;
          xn[i] = (tk >= seq_start && tk < seq_end) ? bf2f(p.projA[(size_t)tk * 2560 + pc]) : 0.f;
        }
      }
#pragma unroll
      for (int i = 0; i < 16; ++i) {
        float v = xv[i] * w0 + xv[i + 1] * w1 + xv[i + 2] * w2;
        if (col < 64) v = 1.f - 2.f * __builtin_amdgcn_rcpf(__expf(2.f * v) + 1.f);
        else if (col >= 128) v = sigmoidf_(v);
        *(bf16_t*)(smem + (half * 16 + i) * ACT_STRIDE + col * 2) = f2bf(v);
      }
      if (half == 0) {
#pragma unroll
        for (int i = 0; i < 18; ++i) xv[i] = xn[i];
      }
    }
  }
  __syncthreads();
  const int hd = hg * 4 + wave;
  const int n = lane & 31, hh = lane >> 5;
  const int tok = tok0 + n;
  const char* actrow = smem + n * ACT_STRIDE;
  const char* center = smem + RAW_OFF + (n + 1) * RAW_STRIDE;
  const int hb = wave * 128;
  float ss = 0.f;
#pragma unroll 1
  for (int tl = 0; tl < 2; ++tl)
#pragma unroll
    for (int g = 0; g < 4; ++g) {
      int c64 = tl * 32 + 8 * g + 4 * hh;
      int ch = hd * 64 + c64;
      float kc[4];
      conv4_lds(center, 512 + hb + c64 * 2, p.rwkv_conv, 512 + ch, kc);
      float4 kkw = *(const float4*)(p.k_k + ch);
      float a0 = kc[0] * kkw.x, a1 = kc[1] * kkw.y, a2 = kc[2] * kkw.z, a3 = kc[3] * kkw.w;
      ss += a0 * a0 + a1 * a1 + a2 * a2 + a3 * a3;
    }
  ss += __shfl_xor(ss, 32);
  const float kkinv = rsqrtf(ss + 1e-12f);
  {
    f32x16 ag[2];
#pragma unroll
    for (int tl = 0; tl < 2; ++tl)
#pragma unroll
      for (int r = 0; r < 16; ++r) ag[tl][r] = 0.f;
#pragma unroll
    for (int ks = 0; ks < 8; ++ks) {
      bf16x8 bfr = *(const bf16x8*)(actrow + (128 + ks * 16 + hh * 8) * 2);
#pragma unroll
      for (int tl = 0; tl < 2; ++tl) {
        bf16x8 af = *(const bf16x8*)(p.wt_g2 + (size_t)(hd * 64 + tl * 32 + n) * 128 + ks * 16 + hh * 8);
        ag[tl] = MFMA(af, bfr, ag[tl]);
      }
    }
#pragma unroll
    for (int tl = 0; tl < 2; ++tl)
#pragma unroll
      for (int g = 0; g < 4; ++g) {
        nt_store2(p.gbuf + Gidx(tok, hd, tl * 8 + 2 * g + hh), pack2(ag[tl][4 * g], ag[tl][4 * g + 1]), pack2(ag[tl][4 * g + 2], ag[tl][4 * g + 3]));
      }
  }
  float bs0 = 0.f, bs1 = 0.f;
#pragma unroll 1
  for (int tl = 0; tl < 2; ++tl) {
    unsigned kcp[8], rp[8], kkp[8];
#pragma unroll
    for (int g = 0; g < 4; ++g) {
      asm volatile("" ::: "memory");
      int c64 = tl * 32 + 8 * g + 4 * hh;
      int ch = hd * 64 + c64;
      float r4[4], k4[4], v4[4];
      conv4_lds(center, hb + c64 * 2, p.rwkv_conv, ch, r4);
      conv4_lds(center, 512 + hb + c64 * 2, p.rwkv_conv, 512 + ch, k4);
      conv4_lds(center, 1024 + hb + c64 * 2, p.rwkv_conv, 1024 + ch, v4);
      float4 kkw = *(const float4*)(p.k_k + ch);
      const float kkwv[4] = {kkw.x, kkw.y, kkw.z, kkw.w};
      kcp[2 * g] = pack2(k4[0], k4[1]); kcp[2 * g + 1] = pack2(k4[2], k4[3]);
      rp[2 * g] = pack2(r4[0], r4[1]); rp[2 * g + 1] = pack2(r4[2], r4[3]);
      kkp[2 * g] = pack2(k4[0] * kkwv[0] * kkinv, k4[1] * kkwv[1] * kkinv);
      kkp[2 * g + 1] = pack2(k4[2] * kkwv[2] * kkinv, k4[3] * kkwv[3] * kkinv);
      const int c4g = c64 >> 2;
      nt_store2(p.SH + SHidx(tok, hd, 0, c4g), rp[2 * g], rp[2 * g + 1]);
      nt_store2(p.SH + SHidx(tok, hd, 1, c4g), pack2(v4[0], v4[1]), pack2(v4[2], v4[3]));
      nt_store2(p.SH + SHidx(tok, hd, 2, c4g), kkp[2 * g], kkp[2 * g + 1]);
    }
#pragma unroll 1
    for (int d = 0; d < 2; ++d) {
      f32x16 aw, aa;
#pragma unroll
      for (int r = 0; r < 16; ++r) { aw[r] = 0.f; aa[r] = 0.f; }
#pragma unroll
      for (int ks = 0; ks < 4; ++ks) {
        bf16x8 bw = *(const bf16x8*)(actrow + (ks * 16 + hh * 8) * 2);
        bf16x8 ba = *(const bf16x8*)(actrow + (64 + ks * 16 + hh * 8) * 2);
        bf16x8 fw = *(const bf16x8*)(p.wt_w2 + (size_t)(d * 512 + hd * 64 + tl * 32 + n) * 64 + ks * 16 + hh * 8);
        bf16x8 fa = *(const bf16x8*)(p.wt_a2 + (size_t)(d * 512 + hd * 64 + tl * 32 + n) * 64 + ks * 16 + hh * 8);
        aw = MFMA(fw, bw, aw);
        aa = MFMA(fa, ba, aa);
      }
      float bsum = 0.f;
#pragma unroll
      for (int g = 0; g < 4; ++g) {
        asm volatile("" ::: "memory");
        int c64 = tl * 32 + 8 * g + 4 * hh;
        int ch = hd * 64 + c64;
        float4 w0v = *(const float4*)(p.w0 + d * 512 + ch);
        float4 a0v = *(const float4*)(p.a0 + d * 512 + ch);
        float4 kav = *(const float4*)(p.k_a + ch);
        float4 rkv = *(const float4*)(p.r_k + ch);
        const float w0a[4] = {w0v.x, w0v.y, w0v.z, w0v.w}, a0a[4] = {a0v.x, a0v.y, a0v.z, a0v.w};
        const float kaa[4] = {kav.x, kav.y, kav.z, kav.w}, rka[4] = {rkv.x, rkv.y, rkv.z, rkv.w};
        float wv[4], kdv[4], bv[4];
#pragma unroll
        for (int i = 0; i < 4; ++i) {
          int r = 4 * g + i;
          wv[i] = __expf(-0.60653065971263342f * sigmoidf_(w0a[i] + aw[r]));
          float a = sigmoidf_(a0a[i] + aa[r]);
          const unsigned kkw_ = kkp[2 * g + (i >> 1)], rw_ = rp[2 * g + (i >> 1)], kcw_ = kcp[2 * g + (i >> 1)];
          kdv[i] = ((i & 1) ? bfhi(kcw_) : bflo(kcw_)) * (1.f + (a - 1.f) * kaa[i]);
          bv[i] = ((i & 1) ? bfhi(kkw_) : bflo(kkw_)) * a;
          bsum += ((i & 1) ? bfhi(rw_) : bflo(rw_)) * kdv[i] * rka[i];
        }
        const int c4g = c64 >> 2;
        nt_store4f(p.DW + DWidx(d, tok, hd, c4g), wv[0], wv[1], wv[2], wv[3]);
        nt_store2(p.DK + DKidx(d, tok, hd, 0, c4g), pack2(kdv[0], kdv[1]), pack2(kdv[2], kdv[3]));
        nt_store2(p.DK + DKidx(d, tok, hd, 1, c4g), pack2(bv[0], bv[1]), pack2(bv[2], bv[3]));
      }
      if (d == 0) bs0 += bsum; else bs1 += bsum;
    }
  }
  bs0 += __shfl_xor(bs0, 32);
  bs1 += __shfl_xor(bs1, 32);
  if (hh == 0) *(float2*)(p.BS + BSidx(tok, hd)) = make_float2(bs0, bs1);
  __syncthreads();
}

#define SCH 16
#define SBUF (SCH * 384)
DI void ld8(const float* p, f32x2 (&o)[4]) {
  float4 t0 = *(const float4*)p, t1 = *(const float4*)(p + 4);
  o[0] = f32x2{t0.x, t0.y}; o[1] = f32x2{t0.z, t0.w}; o[2] = f32x2{t1.x, t1.y}; o[3] = f32x2{t1.z, t1.w};
}
DI float dot8(const f32x2 (&a)[4], const f32x2 (&b)[4]) {
  f32x2 p = a[0] * b[0] + a[1] * b[1];
  f32x2 q = a[2] * b[2] + a[3] * b[3];
  p = p + q;
  return p.x + p.y;
}
DI void scan_unit(const Params& p, int tok0, int L, int hd, int d, int rh, const float* s0, float* sout, char* smem) {
  __builtin_amdgcn_s_setprio(3);
  const int tid = threadIdx.x;
  const int row = rh * 32 + (tid >> 3), seg = tid & 7;
  f32x2 S[4];
  if (s0) {
    ld8(s0 + row * 64 + seg * 8, S);
  } else {
#pragma unroll
    for (int j = 0; j < 4; ++j) S[j] = f32x2{0.f, 0.f};
  }
  float* buf = (float*)smem;
  const int nchunk = L / SCH;
  struct Stg { uint2 a[2], b[2], k[2]; uint4 w[2]; };
  Stg G0, G1;
#pragma unroll
  for (int q = 0; q < 2; ++q) { G0.a[q] = G0.b[q] = G0.k[q] = make_uint2(0, 0); G0.w[q] = make_uint4(0, 0, 0, 0); }
  G1 = G0;
  const int s_jt = tid & 7, s_g = (tid >> 3) & 15, s_hi = tid >> 7;
  auto gload = [&](int c, Stg& r) {
#pragma unroll
    for (int q = 0; q < 2; ++q) {
      const int tk = tok0 + (d == 0 ? c * SCH : L - SCH - c * SCH) + s_jt + 8 * q;
      r.a[q] = *(const uint2*)(p.SH + SHidx(tk, hd, s_hi, s_g));
      r.k[q] = *(const uint2*)(p.DK + DKidx(d, tk, hd, s_hi, s_g));
      if (s_hi == 0) r.b[q] = *(const uint2*)(p.SH + SHidx(tk, hd, 2, s_g));
      else r.w[q] = *(const uint4*)(p.DW + DWidx(d, tk, hd, s_g));
    }
  };
  auto put4 = [&](float* dst, uint2 v) { *(float4*)dst = make_float4(bflo(v.x), bfhi(v.x), bflo(v.y), bfhi(v.y)); };
  auto swrite = [&](int b, const Stg& r) {
#pragma unroll
    for (int q = 0; q < 2; ++q) {
      const int jt = s_jt + 8 * q;
      float* bb = buf + b * SBUF + ((d == 0) ? jt : SCH - 1 - jt) * 384 + s_g * 4;
      put4(bb + (s_hi == 0 ? 4 : 5) * 64, r.a[q]);
      put4(bb + (s_hi == 0 ? 3 : 2) * 64, r.k[q]);
      if (s_hi == 0) put4(bb, r.b[q]);
      else *(uint4*)(bb + 64) = r.w[q];
    }
  };
  gload(0, G0);
  gload(1, G1);
  swrite(0, G0);
  swrite(1, G1);
  if (2 < nchunk) gload(2, G0);
  __syncthreads();
  float sa;
  {
    f32x2 k0[4];
    ld8(buf + seg * 8, k0);
    sa = -red8(dot8(S, k0));
  }
  float ykeep = 0.f, ykeep2 = 0.f;
  int b0 = 0, b1 = 1, b2 = 2;
  auto chunk_body = [&](int c, Stg& iS, const Stg& wS) {
    const bool more2 = (c + 2 < nchunk);
    if (c + 3 < nchunk) gload(c + 3, iS);
    const float* cb = buf + b0 * SBUF + seg * 8;
    const float* nbp = (c + 1 < nchunk) ? buf + b1 * SBUF + seg * 8 : cb + (SCH - 1) * 384;
    const float* vrow = buf + b0 * SBUF + 320 + row;
    f32x2 w[4], bb[4], kd[4], r[4], kn[4];
    float vv;
    ld8(cb + 64, w); ld8(cb + 192, kd); ld8(cb + 384, kn); ld8(cb + 128, bb); ld8(cb + 256, r);
    vv = vrow[0];
#pragma unroll
    for (int i = 0; i < SCH; ++i) {
      asm volatile("" ::: "memory");
      f32x2 nw[4], nbb[4], nkd[4], nr[4], nkn[4];
      float nvv = 0.f;
      if (i < SCH - 1) {
        const float* st = cb + (i + 1) * 384;
        ld8(st + 64, nw); ld8(st + 192, nkd);
        ld8((i + 1 < SCH - 1) ? st + 384 : nbp, nkn);
        ld8(st + 128, nbb); ld8(st + 256, nr);
        nvv = vrow[(i + 1) * 384];
      }
      const f32x2 vv2 = {vv, vv};
      f32x2 U[4];
#pragma unroll
      for (int j = 0; j < 4; ++j) U[j] = S[j] * w[j] + vv2 * kd[j];
      const float Ap = dot8(U, kn), Bp = dot8(bb, kn);
      const f32x2 sa2 = {sa, sa};
#pragma unroll
      for (int j = 0; j < 4; ++j) S[j] = U[j] + sa2 * bb[j];
      const float yv = red8(dot8(S, r));
      sa = -red8(Ap + sa * Bp);
      if (seg == (i & 7)) { if (i < 8) ykeep = yv; else ykeep2 = yv; }
      if (i < SCH - 1) {
#pragma unroll
        for (int j = 0; j < 4; ++j) { w[j] = nw[j]; bb[j] = nbb[j]; kd[j] = nkd[j]; r[j] = nr[j]; kn[j] = nkn[j]; }
        vv = nvv;
      }
    }
#pragma unroll
    for (int q = 0; q < 2; ++q) {
      const int ii = c * SCH + seg + 8 * q;
      const int tt = (d == 0) ? ii : (L - 1 - ii);
      p.Y[((size_t)d * NTOK + tok0 + tt) * 512 + hd * 64 + row] = q ? ykeep2 : ykeep;
    }
    if (more2) swrite(b2, wS);
    __syncthreads();
    const int t_ = b0; b0 = b1; b1 = b2; b2 = t_;
  };
#pragma unroll 1
  for (int c = 0; c < nchunk; c += 2) {
    chunk_body(c + 0, G1, G0);
    chunk_body(c + 1, G0, G1);
  }
  if (sout) {
    *(float4*)(sout + row * 64 + seg * 8) = make_float4(S[0].x, S[0].y, S[1].x, S[1].y);
    *(float4*)(sout + row * 64 + seg * 8 + 4) = make_float4(S[2].x, S[2].y, S[3].x, S[3].y);
  }
  __builtin_amdgcn_s_setprio(0);
}

#define KV_STRIDE 144
DI void attn_unit(const bf16_t* __restrict__ Q, const bf16_t* __restrict__ Kb, const bf16_t* __restrict__ Vt, int LK, bf16_t* __restrict__ O, char* smem) {
  const int tid = threadIdx.x, lane = tid & 63, wave = tid >> 6;
  const int n = lane & 31, hh = lane >> 5;
  char* Ks = smem;
  char* Vs = smem + 64 * KV_STRIDE;
  bf16x8 qf[4];
#pragma unroll
  for (int ks = 0; ks < 4; ++ks) qf[ks] = *(const bf16x8*)(Q + (size_t)(wave * 32 + n) * 64 + ks * 16 + hh * 8);
  f32x16 ot[2];
#pragma unroll
  for (int dt = 0; dt < 2; ++dt)
#pragma unroll
    for (int r = 0; r < 16; ++r) ot[dt][r] = 0.f;
  float mrun = -1e30f, lrun = 0.f;
  const int ntile = LK >> 6;
  const int lrow = tid >> 3, lc = tid & 7;
  uint4 rk0, rk1, rv0, rv1;
  rk0 = *(const uint4*)(Kb + (size_t)(lrow) * 64 + lc * 8);
  rk1 = *(const uint4*)(Kb + (size_t)(lrow + 32) * 64 + lc * 8);
  rv0 = *(const uint4*)(Vt + (size_t)(lrow) * LK + lc * 8);
  rv1 = *(const uint4*)(Vt + (size_t)(lrow + 32) * LK + lc * 8);
  for (int kt = 0; kt < ntile; ++kt) {
    *(uint4*)(Ks + (lrow) * KV_STRIDE + lc * 16) = rk0;
    *(uint4*)(Ks + (lrow + 32) * KV_STRIDE + lc * 16) = rk1;
    *(uint4*)(Vs + (lrow) * KV_STRIDE + lc * 16) = rv0;
    *(uint4*)(Vs + (lrow + 32) * KV_STRIDE + lc * 16) = rv1;
    __syncthreads();
    if (kt + 1 < ntile) {
      rk0 = *(const uint4*)(Kb + (size_t)((kt + 1) * 64 + lrow) * 64 + lc * 8);
      rk1 = *(const uint4*)(Kb + (size_t)((kt + 1) * 64 + lrow + 32) * 64 + lc * 8);
      rv0 = *(const uint4*)(Vt + (size_t)(lrow) * LK + (kt + 1) * 64 + lc * 8);
      rv1 = *(const uint4*)(Vt + (size_t)(lrow + 32) * LK + (kt + 1) * 64 + lc * 8);
    }
    f32x16 st[2];
#pragma unroll
    for (int kb = 0; kb < 2; ++kb) {
#pragma unroll
      for (int r = 0; r < 16; ++r) st[kb][r] = 0.f;
#pragma unroll
      for (int ks = 0; ks < 4; ++ks) {
        bf16x8 af = *(const bf16x8*)(Ks + (kb * 32 + n) * KV_STRIDE + (ks * 2 + hh) * 16);
        st[kb] = MFMA(af, qf[ks], st[kb]);
      }
    }
    float mx = st[0][0];
#pragma unroll
    for (int kb = 0; kb < 2; ++kb)
#pragma unroll
      for (int r = 0; r < 16; ++r) mx = fmaxf(mx, st[kb][r]);
    mx = fmaxf(mx, __shfl_xor(mx, 32));
    const float mnew = fmaxf(mrun, mx);
    const float alpha = __builtin_amdgcn_exp2f(mrun - mnew);
    mrun = mnew;
    float ps = 0.f;
#pragma unroll
    for (int kb = 0; kb < 2; ++kb)
#pragma unroll
      for (int r = 0; r < 16; ++r) { float e = __builtin_amdgcn_exp2f(st[kb][r] - mnew); st[kb][r] = e; ps += e; }
    lrun = lrun * alpha + ps;
#pragma unroll
    for (int dt = 0; dt < 2; ++dt)
#pragma unroll
      for (int r = 0; r < 16; ++r) ot[dt][r] *= alpha;
#pragma unroll
    for (int kb = 0; kb < 2; ++kb)
#pragma unroll
      for (int s = 0; s < 2; ++s) {
        uint4 pk = make_uint4(pack2(st[kb][8 * s + 0], st[kb][8 * s + 1]), pack2(st[kb][8 * s + 2], st[kb][8 * s + 3]),
                              pack2(st[kb][8 * s + 4], st[kb][8 * s + 5]), pack2(st[kb][8 * s + 6], st[kb][8 * s + 7]));
        bf16x8 pf = __builtin_bit_cast(bf16x8, pk);
#pragma unroll
        for (int dt = 0; dt < 2; ++dt) {
          const char* vp = Vs + (dt * 32 + n) * KV_STRIDE + (kb * 32 + 16 * s + 4 * hh) * 2;
          uint2 lo = *(const uint2*)(vp), hi = *(const uint2*)(vp + 16);
          bf16x8 vf = __builtin_bit_cast(bf16x8, make_uint4(lo.x, lo.y, hi.x, hi.y));
          ot[dt] = MFMA(vf, pf, ot[dt]);
        }
      }
    __syncthreads();
  }
  lrun += __shfl_xor(lrun, 32);
  const float inv = 1.f / lrun;
#pragma unroll
  for (int dt = 0; dt < 2; ++dt)
#pragma unroll
    for (int g = 0; g < 4; ++g) {
      int dd = dt * 32 + 8 * g + 4 * hh;
      *(uint2*)(O + (size_t)(wave * 32 + n) * 512 + dd) =
          make_uint2(pack2(ot[dt][4 * g] * inv, ot[dt][4 * g + 1] * inv), pack2(ot[dt][4 * g + 2] * inv, ot[dt][4 * g + 3] * inv));
    }
}

DI void phase4(const Params& p, int u, char* smem) {
  if (u < 128) {
    const int scan = u >> 1, rh = u & 1;
    const int b = scan >> 4, hd = (scan >> 1) & 7, d = scan & 1;
    scan_unit(p, 4096 + b * 1024, 1024, hd, d, rh, p.state + ((size_t)(b * 2 + d) * 8 + hd) * 4096, nullptr, smem);
  } else if (u < 256) {
#pragma unroll 1
    for (int j = 0; j < 4; ++j) {
      const int cu = (u - 128) * 4 + j;
      const int scan = cu >> 1, rh = cu & 1;
      const int s = scan >> 4, hd = (scan >> 1) & 7, d = scan & 1;
      scan_unit(p, s * 256, 256, hd, d, rh, nullptr, p.out + (size_t)2 * 4194304 + 2 * 524288 + ((size_t)(s * 2 + d) * 8 + hd) * 4096, smem);
    }
  } else {
    const int a = u - 256;
    {
      const int qb = a & 7, hd = (a >> 3) & 7, b = a >> 6;
      const int kvh = hd >> 2;
      attn_unit(p.q + (size_t)4096 * 512 + ((size_t)(b * 8 + hd) * 1024 + qb * 128) * 64, p.Kl + (size_t)(b * 2 + kvh) * 1536 * 64,
                p.Vtl + (size_t)(b * 2 + kvh) * 64 * 1536, 1536, p.attn_o + (size_t)(4096 + b * 1024 + qb * 128) * 512 + hd * 64, smem);
    }
    {
      const int qb = a & 1, hd = (a >> 1) & 7, s = a >> 4;
      const int kvh = hd >> 2;
      attn_unit(p.q + ((size_t)(s * 8 + hd) * 256 + qb * 128) * 64, p.Kc + (size_t)(s * 2 + kvh) * 256 * 64,
                p.Vtc + (size_t)(s * 2 + kvh) * 64 * 256, 256, p.attn_o + (size_t)(s * 256 + qb * 128) * 512 + hd * 64, smem);
    }
  }
}

DI void rwkv_final_tok4(const Params& p, int tok0) {
  const int lane = threadIdx.x & 63;
  const int hd = lane >> 3, sub = lane & 7;
  const int ch = hd * 64 + sub * 8;
  float4 ya[4][2], yb[4][2];
#pragma unroll
  for (int t = 0; t < 4; ++t) {
    const float* y0 = p.Y + (size_t)(tok0 + t) * 512 + ch;
    const float* y1 = p.Y + ((size_t)NTOK + tok0 + t) * 512 + ch;
    ya[t][0] = *(const float4*)y0; ya[t][1] = *(const float4*)(y0 + 4);
    yb[t][0] = *(const float4*)y1; yb[t][1] = *(const float4*)(y1 + 4);
  }
  uint4 vr[2][2], gr[2][2];
#pragma unroll
  for (int c = 0; c < 2; ++c) {
    const uint4* vp = (const uint4*)(p.SH + SHidx(tok0, hd, 1, sub * 2 + c));
    const uint4* gp = (const uint4*)(p.gbuf + Gidx(tok0, hd, sub * 2 + c));
    vr[c][0] = vp[0]; vr[c][1] = vp[1];
    gr[c][0] = gp[0]; gr[c][1] = gp[1];
  }
  float2 bsv[4];
#pragma unroll
  for (int t = 0; t < 4; ++t) bsv[t] = *(const float2*)(p.BS + BSidx(tok0 + t, hd));
  float4 lg0 = *(const float4*)(p.ln_g + ch), lg1 = *(const float4*)(p.ln_g + ch + 4);
  float4 lb0 = *(const float4*)(p.ln_b + ch), lb1 = *(const float4*)(p.ln_b + ch + 4);
  const float lg[8] = {lg0.x, lg0.y, lg0.z, lg0.w, lg1.x, lg1.y, lg1.z, lg1.w};
  const float lb[8] = {lb0.x, lb0.y, lb0.z, lb0.w, lb1.x, lb1.y, lb1.z, lb1.w};
#pragma unroll
  for (int t = 0; t < 4; ++t) {
    float y[8] = {ya[t][0].x + yb[t][0].x, ya[t][0].y + yb[t][0].y, ya[t][0].z + yb[t][0].z, ya[t][0].w + yb[t][0].w,
                  ya[t][1].x + yb[t][1].x, ya[t][1].y + yb[t][1].y, ya[t][1].z + yb[t][1].z, ya[t][1].w + yb[t][1].w};
    float s = 0.f;
#pragma unroll
    for (int j = 0; j < 8; ++j) s += y[j];
    const float mu = red8(s) * (1.f / 64.f);
    float vs = 0.f;
#pragma unroll
    for (int j = 0; j < 8; ++j) { y[j] -= mu; vs += y[j] * y[j]; }
    const float rstd = rsqrtf(red8(vs) * (1.f / 64.f) + 64e-5f);
    const float bsum = bsv[t].x + bsv[t].y;
    unsigned vw[4], gw[4];
#pragma unroll
    for (int c = 0; c < 2; ++c) {
      const uint4 vq = vr[c][t >> 1], gq = gr[c][t >> 1];
      vw[2 * c] = (t & 1) ? vq.z : vq.x; vw[2 * c + 1] = (t & 1) ? vq.w : vq.y;
      gw[2 * c] = (t & 1) ? gq.z : gq.x; gw[2 * c + 1] = (t & 1) ? gq.w : gq.y;
    }
    const float vv[8] = {bflo(vw[0]), bfhi(vw[0]), bflo(vw[1]), bfhi(vw[1]), bflo(vw[2]), bfhi(vw[2]), bflo(vw[3]), bfhi(vw[3])};
    const float gg[8] = {bflo(gw[0]), bfhi(gw[0]), bflo(gw[1]), bfhi(gw[1]), bflo(gw[2]), bfhi(gw[2]), bflo(gw[3]), bfhi(gw[3])};
    float o[8];
#pragma unroll
    for (int j = 0; j < 8; ++j) o[j] = (y[j] * rstd * lg[j] + lb[j] + bsum * vv[j]) * gg[j];
    *(uint4*)(p.rwkv_o + (size_t)(tok0 + t) * 512 + ch) = make_uint4(pack2(o[0], o[1]), pack2(o[2], o[3]), pack2(o[4], o[5]), pack2(o[6], o[7]));
  }
}

DI void unpack8(uint4 v, float (&o)[8]) {
  o[0] = bflo(v.x); o[1] = bfhi(v.x); o[2] = bflo(v.y); o[3] = bfhi(v.y); o[4] = bflo(v.z); o[5] = bfhi(v.z); o[6] = bflo(v.w); o[7] = bfhi(v.w);
}
DI void ffn_act_unit(const Params& p, int u) {
  const int item = u * 256 + threadIdx.x;
  const int er = item / 2816, chn = item - er * 2816;
  const int blk = er >> 1, last = er & 1;
  const bool firstblk = blk < 32 ? ((blk & 1) == 0) : (((blk - 32) & 7) == 0);
  const bool lastblk = blk < 32 ? ((blk & 1) == 1) : (((blk - 32) & 7) == 7);
  const bf16_t* e = p.edge + (size_t)blk * 4 * 5632;
  float pu = 0.f, pg = 0.f, cu, cg, nu = 0.f, ng = 0.f;
  if (!last) {
    if (!firstblk) { pu = bf2f(e[-5632 + chn]); pg = bf2f(e[-5632 + 2816 + chn]); }
    cu = bf2f(e[chn]); cg = bf2f(e[2816 + chn]);
    nu = bf2f(e[5632 + chn]); ng = bf2f(e[5632 + 2816 + chn]);
  } else {
    pu = bf2f(e[2 * 5632 + chn]); pg = bf2f(e[2 * 5632 + 2816 + chn]);
    cu = bf2f(e[3 * 5632 + chn]); cg = bf2f(e[3 * 5632 + 2816 + chn]);
    if (!lastblk) { nu = bf2f(e[4 * 5632 + chn]); ng = bf2f(e[4 * 5632 + 2816 + chn]); }
  }
  const float uu = pu * p.ffn_conv[chn] + cu * p.ffn_conv[5632 + chn] + nu * p.ffn_conv[2 * 5632 + chn];
  const float gg = pg * p.ffn_conv[2816 + chn] + cg * p.ffn_conv[5632 + 2816 + chn] + ng * p.ffn_conv[2 * 5632 + 2816 + chn];
  p.act[(size_t)(blk * 128 + (last ? 127 : 0)) * 2816 + chn] = f2bf(gg * sigmoidf_(gg) * uu);
}

#define NPHASE 13
template <int PH> DI void run_phase(const Params& p, char* smem) {
  const int nb = gridDim.x;
  if (PH == 0) for (int u = blockIdx.x; u < P0_MOD_UNITS; u += nb) phase0(p, u, smem);
  if (PH == 1) for (int u = blockIdx.x; u < 512 + (P0_UNITS - P0_MOD_UNITS); u += nb) {
    if (u < 512) norm_rows<0>(p, u);
    else phase0(p, u - 512 + P0_MOD_UNITS, smem);
  }
  if (PH == 2) for (int u = blockIdx.x; u < 32 * 32 + 64 * 4; u += nb) {
    if (u < 1024) gemm_unit_wide<0>(p, u & 31, u >> 5, smem);
    else gemm_unit<0>(p, (u - 1024) + 64 * 32, smem);
  }
  if (PH == 3) for (int u = blockIdx.x; u < 512 + 512 + 64 + 256; u += nb) {
    if (u < 512) rwkv_prep_unit(p, u, smem);
    else if (u < 1024) attn_prep_unit(p, u - 512);
    else if (u < 1024 + 64) cache_conv_unit(p, u - 1024, smem);
    else v_prep_unit(p, u - 1088);
  }
  if (PH == 4) for (int u = blockIdx.x; u < 512; u += nb) phase4(p, u, smem);
  if (PH == 5) for (int u = blockIdx.x; u < 512; u += nb) rwkv_final_tok4(p, u * 16 + (threadIdx.x >> 6) * 4);
  if (PH == 6) {
#pragma unroll 1
    for (int u = blockIdx.x; u < 64 * 8; u += nb) gemm_unit<1>(p, u, smem);
    asm volatile("" ::: "memory");
#pragma unroll 1
    for (int u = blockIdx.x; u < 64 * 8; u += nb) gemm_unit<5>(p, u, smem);
  }
  if (PH == 7) for (int u = blockIdx.x; u < 64 * 8; u += nb) gemm_unit<2>(p, u, smem);
  if (PH == 8) for (int u = blockIdx.x; u < 512; u += nb) norm_rows<1>(p, u);
  if (PH == 9) for (int u = blockIdx.x; u < 32 * 44; u += nb) gemm_unit_wide<3>(p, u & 31, u >> 5, smem);
  if (PH == 10) for (int u = blockIdx.x; u < 1408; u += nb) ffn_act_unit(p, u);
  if (PH == 11) for (int u = blockIdx.x; u < 64 * 8; u += nb) gemm_unit<4>(p, u, smem);
  if (PH == 12) for (int u = blockIdx.x; u < 512; u += nb) norm_rows<2>(p, u);
}


#define XB_TMO      128
#define XB_XCNT(j)  (256  + 64 * (j))
#define XB_XSUB(j)  (1280 + 64 * (j))
#define XB_XGEN(j)  (2304 + 64 * (j))
#define XB_TOP      3328
#define XB_TOPGEN   3392
#define XCD_BAR_WORDS 3456
#define XB_SPIN_CAP (1u << 18)
#define LAS __attribute__((address_space(3)))

__device__ __forceinline__ unsigned xb_ld(unsigned* p)              { return __hip_atomic_load(p, __ATOMIC_RELAXED, __HIP_MEMORY_SCOPE_AGENT); }
__device__ __forceinline__ unsigned xb_add(unsigned* p, unsigned v) { return __hip_atomic_fetch_add(p, v, __ATOMIC_RELAXED, __HIP_MEMORY_SCOPE_AGENT); }
__device__ __forceinline__ unsigned xb_xcc_id() { return (unsigned)__builtin_amdgcn_s_getreg((3 << 11) | 20) & 0xFu; }
#define XB_SPIN(cond, bar) do { unsigned _sp = 0; while (cond) { __builtin_amdgcn_s_sleep(1); \
    if ((++_sp & 255u) == 0u) { if (xb_ld(&(bar)[XB_TMO])) break; if (_sp > XB_SPIN_CAP) { atomicAdd(&(bar)[XB_TMO], 1u); break; } } } } while (0)

struct XcdBarrier {
    unsigned* bar; unsigned x;
    volatile LAS unsigned* st;
};

__device__ __forceinline__ XcdBarrier xcd_barrier_post(unsigned* bar, volatile LAS unsigned* st) {
    XcdBarrier b; b.bar = bar; b.x = xb_xcc_id(); b.st = st;
    if (threadIdx.x == 0) (void)xb_add(&bar[XB_XCNT(b.x)], 1u);
    return b;
}
__device__ __forceinline__ void xcd_barrier_complete(unsigned* bar, unsigned x, unsigned& nloc, unsigned& nx) {
    const unsigned G = gridDim.x * gridDim.y * gridDim.z;
    unsigned sum, cnt, mine, sp = 0u;
    for (;;) {
        sum = 0u; cnt = 0u; mine = 0u;
#pragma unroll
        for (unsigned j = 0; j < 16; ++j) { const unsigned c = xb_ld(&bar[XB_XCNT(j)]); sum += c; cnt += (c > 0u) ? 1u : 0u; mine = (j == x) ? c : mine; }
        if (sum == G) break;
        __builtin_amdgcn_s_sleep(1);
        if ((++sp & 255u) == 0u) { if (xb_ld(&bar[XB_TMO])) break; if (sp > XB_SPIN_CAP) { atomicAdd(&bar[XB_TMO], 1u); break; } }
    }
    nloc = mine > 0u ? mine : 1u; nx = cnt > 0u ? cnt : 1u;
}

__device__ __forceinline__ void xcd_barrier(const XcdBarrier& b) {
    asm volatile("s_waitcnt vmcnt(0)" ::: "memory");
    __syncthreads();
    if (threadIdx.x == 0) {
        unsigned* bar = b.bar;
        __builtin_amdgcn_s_waitcnt(0);
        unsigned nloc = b.st[0], nx = b.st[1];
        if (nloc == 0u) { xcd_barrier_complete(bar, b.x, nloc, nx); b.st[0] = nloc; b.st[1] = nx; }
        const unsigned old = xb_add(&bar[XB_XSUB(b.x)], 1u);
        const unsigned gen = old / nloc;
        if (old + 1u == (gen + 1u) * nloc) {
            __builtin_amdgcn_fence(__ATOMIC_RELEASE, "agent");
            asm volatile("s_waitcnt vmcnt(0)" ::: "memory");
            const unsigned og = xb_add(&bar[XB_TOP], 1u);
            const unsigned tg = og / nx;
            if (og + 1u == (tg + 1u) * nx) xb_add(&bar[XB_TOPGEN], 1u);
            else XB_SPIN(xb_ld(&bar[XB_TOPGEN]) == tg, bar);
            __builtin_amdgcn_fence(__ATOMIC_ACQUIRE, "agent");
            xb_add(&bar[XB_XGEN(b.x)], 1u);
            asm volatile("s_waitcnt vmcnt(0)" ::: "memory");
        } else {
            XB_SPIN(xb_ld(&bar[XB_XGEN(b.x)]) == gen, bar);
            __builtin_amdgcn_fence(__ATOMIC_ACQUIRE, "agent");
            asm volatile("s_waitcnt vmcnt(0)" ::: "memory");
        }
    }
    __syncthreads();
}

#if FUSED
__global__ void __launch_bounds__(256, 2) fwd_megakernel(Params p) {
  __shared__ __attribute__((aligned(16))) char smem[SMEM_BYTES];
  cg::grid_group grid = cg::this_grid();
  if (p.never) grid.sync();
  __shared__ uint4 xb_words;
  if (threadIdx.x == 0) xb_words = make_uint4(0u, 0u, 0u, 0u);
  __syncthreads();
  XcdBarrier xb = xcd_barrier_post(p.bar, (volatile LAS unsigned*)&xb_words);
#define GB() xcd_barrier(xb)
  run_phase<0>(p, smem); GB();
  run_phase<1>(p, smem); GB();
  run_phase<2>(p, smem); GB();
  run_phase<3>(p, smem); GB();
  run_phase<4>(p, smem); GB();
  run_phase<5>(p, smem); GB();
  run_phase<6>(p, smem); GB();
  run_phase<7>(p, smem); GB();
  run_phase<8>(p, smem); GB();
  run_phase<9>(p, smem); GB();
  run_phase<10>(p, smem); GB();
  run_phase<11>(p, smem); GB();
  run_phase<12>(p, smem);
}
#else
template <int PH> __global__ void __launch_bounds__(256, 2) phase_kernel(Params p) {
  __shared__ __attribute__((aligned(16))) char smem[SMEM_BYTES];
  run_phase<PH>(p, smem);
}
#endif

extern "C" void kernel_launch(void* const* d_in, const int* in_sizes, int n_in, void* d_out, int out_size, void* d_ws,
                              size_t ws_size, hipStream_t stream) {
  Params p{};
  const float** fp = (const float**)&p;
  for (int i = 0; i < 32; ++i) fp[i] = (const float*)d_in[i];
  p.out = (float*)d_out;
  char* w = (char*)d_ws;
  size_t off = 0;
  auto take = [&](size_t bytes) { char* r = w + off; off += (bytes + 255) & ~(size_t)255; return r; };
  p.mod = (float*)take(5 * 6144 * 4);
  p.wt_in = (bf16_t*)take((size_t)4608 * 1024 * 2);
  p.wt_attn = (bf16_t*)take((size_t)1024 * 512 * 2);
  p.wt_rwkv = (bf16_t*)take((size_t)1024 * 512 * 2);
  p.wt_out = (bf16_t*)take((size_t)1024 * 1024 * 2);
  p.wt_up = (bf16_t*)take((size_t)5632 * 1024 * 2);
  p.wt_down = (bf16_t*)take((size_t)1024 * 2816 * 2);
  p.wt_w2 = (bf16_t*)take((size_t)2 * 512 * 64 * 2);
  p.wt_a2 = (bf16_t*)take((size_t)2 * 512 * 64 * 2);
  p.wt_g2 = (bf16_t*)take((size_t)512 * 128 * 2);
  p.h = (bf16_t*)take((size_t)NTOK * 1024 * 2);
  p.attn_o = p.h;
  p.rwkv_o = p.h + (size_t)NTOK * 512;
  p.projA = (bf16_t*)take((size_t)NTOK * 2560 * 2);
  p.gates = (bf16_t*)take((size_t)NTOK * 2048 * 2);
  p.Y = (float*)p.projA;
  p.act = p.projA;
  p.SH = (bf16_t*)take((size_t)NTOK * 8 * 192 * 2);
  p.DW = (float*)take((size_t)2 * NTOK * 512 * 4);
  p.DK = (bf16_t*)take((size_t)2 * NTOK * 8 * 128 * 2);
  p.up = p.SH;
  p.edge = (bf16_t*)take((size_t)64 * 4 * 5632 * 2);
  p.gbuf = (bf16_t*)take((size_t)NTOK * 512 * 2);
  p.BS = (float*)take((size_t)NTOK * 8 * 2 * 4);
  p.q = (bf16_t*)take((size_t)NTOK * 512 * 2);
  p.Kc = (bf16_t*)take((size_t)16 * 2 * 256 * 64 * 2);
  p.Kl = (bf16_t*)take((size_t)4 * 2 * 1536 * 64 * 2);
  p.Vtc = (bf16_t*)take((size_t)16 * 2 * 256 * 64 * 2);
  p.Vtl = (bf16_t*)take((size_t)4 * 2 * 1536 * 64 * 2);
  p.merged = (bf16_t*)take((size_t)NTOK * 1024 * 2);
  p.bar = (unsigned*)take(XCD_BAR_WORDS * 4);
  p.never = 0;
  p.pad_ = 0;
  if (off > ws_size) { fprintf(stderr, "workspace too small: need %zu have %zu\n", off, ws_size); return; }
#if FUSED
  static int grid_blocks = 0;
  if (!grid_blocks) {
    int dev = 0, cus = 0, per_cu = 0;
    hipGetDevice(&dev);
    hipDeviceGetAttribute(&cus, hipDeviceAttributeMultiprocessorCount, dev);
    hipOccupancyMaxActiveBlocksPerMultiprocessor(&per_cu, fwd_megakernel, 256, 0);
    if (per_cu > 2) per_cu = 2;
    if (per_cu < 1) per_cu = 1;
    grid_blocks = cus * per_cu;
  }
  hipMemsetAsync(p.bar, 0, XCD_BAR_WORDS * 4, stream);
  void* args[] = {&p};
  hipError_t e = hipLaunchCooperativeKernel((void*)fwd_megakernel, dim3(grid_blocks), dim3(256), args, 0, stream);
  if (e != hipSuccess) fprintf(stderr, "cooperative launch failed: %s (grid %d)\n", hipGetErrorString(e), grid_blocks);
#else
  const int G = 1024;
  phase_kernel<0><<<G, 256, 0, stream>>>(p);
  phase_kernel<1><<<G, 256, 0, stream>>>(p);
  phase_kernel<2><<<G, 256, 0, stream>>>(p);
  phase_kernel<3><<<G, 256, 0, stream>>>(p);
  phase_kernel<4><<<512, 256, 0, stream>>>(p);
  phase_kernel<5><<<G, 256, 0, stream>>>(p);
  phase_kernel<6><<<G, 256, 0, stream>>>(p);
  phase_kernel<7><<<G, 256, 0, stream>>>(p);
  phase_kernel<8><<<G, 256, 0, stream>>>(p);
  phase_kernel<9><<<G, 256, 0, stream>>>(p);
  phase_kernel<10><<<G, 256, 0, stream>>>(p);
  phase_kernel<11><<<G, 256, 0, stream>>>(p);
  phase_kernel<12><<<G, 256, 0, stream>>>(p);
#endif
}
```
